# Optimizing an MI355X kernel written in HIP

```python
import jax, jax.numpy as jnp
from jax import lax
import numpy as np

D_MODEL = 1024
BATCH = 8
SEQ = 4096
DEPTH = 1

D_MIX = D_MODEL
D_LRU = 512
LRU_BLOCKS = 8
LRU_BLOCK_W = D_LRU // LRU_BLOCKS
LRU_C = 8.0
D_GDN = D_MIX - D_LRU
GDN_HEADS = 4
GDN_HEAD_DIM = D_GDN // GDN_HEADS
CONV_W = 4
CHUNK = 64
N_GROUPS = 4
EXPERTS_PER_GROUP = 8
N_EXPERTS = N_GROUPS * EXPERTS_PER_GROUP
TOP_K = 2
D_EXPERT = 512
MOE_BLOCK = 256
D_PLE = 256
EPS = 1e-6
IN_COLS = 2 * D_LRU + 4 * D_GDN + 2 * GDN_HEADS

kernel_name = 'hymba_rglru_gdn_hmoe_layer'


def rmsnorm(x, g):
    xf = x.astype(jnp.float32)
    return xf * lax.rsqrt(jnp.mean(xf * xf, axis=-1, keepdims=True) + EPS) * g


def l2norm(x):
    return x * lax.rsqrt(jnp.sum(x * x, axis=-1, keepdims=True) + EPS)


def causal_depthwise_conv(x, w):
    s = x.shape[1]
    kw = w.shape[0]
    xp = jnp.pad(x, ((0, 0), (kw - 1, 0), (0, 0)))
    return sum(xp[:, j:j + s] * w[j] for j in range(kw))


def rglru_group(xb, gb, conv_w, conv_b, wa, ba, wi, bi, lam, out_g):
    bsz, s, _ = xb.shape
    xc = causal_depthwise_conv(xb, conv_w) + conv_b
    xblk = xc.reshape(bsz, s, LRU_BLOCKS, LRU_BLOCK_W)
    r = jax.nn.sigmoid(jnp.einsum('bsnc,ncd->bsnd', xblk, wa).reshape(bsz, s, D_LRU) + ba)
    i = jax.nn.sigmoid(jnp.einsum('bsnc,ncd->bsnd', xblk, wi).reshape(bsz, s, D_LRU) + bi)
    log_a = LRU_C * r * jax.nn.log_sigmoid(lam)
    a = jnp.exp(log_a)
    u = jnp.sqrt(-jnp.expm1(2.0 * log_a)) * (i * xc)

    def combine(c1, c2):
        a1, b1 = c1
        a2, b2 = c2
        return a1 * a2, a2 * b1 + b2

    _, h = lax.associative_scan(combine, (a, u), axis=1)
    return rmsnorm(h * jax.nn.gelu(gb), out_g)


def chunked_gated_delta_rule(q, k, v, beta, g):
    bsz, s, nh, dk = q.shape
    dv = v.shape[-1]
    n = s // CHUNK

    def to_chunks(t):
        return t.reshape(bsz, n, CHUNK, nh, -1).transpose(1, 0, 3, 2, 4)

    qc = to_chunks(q) * (dk ** -0.5)
    kc = to_chunks(k)
    vc = to_chunks(v)
    bc = to_chunks(beta[..., None])[..., 0]
    gc = jnp.cumsum(to_chunks(g[..., None])[..., 0], axis=-1)
    causal = jnp.tril(jnp.ones((CHUNK, CHUNK), dtype=bool))
    strict = jnp.tril(jnp.ones((CHUNK, CHUNK), dtype=bool), k=-1)
    diff = gc[..., :, None] - gc[..., None, :]
    decay = jnp.where(causal, jnp.exp(jnp.where(causal, diff, 0.0)), 0.0)
    kb = kc * bc[..., None]
    kkt = jnp.einsum('nbhid,nbhjd->nbhij', kb, kc) * decay
    m = jnp.eye(CHUNK, dtype=kkt.dtype) + jnp.where(strict, kkt, 0.0)
    rhs = jnp.concatenate([vc * bc[..., None], kb * jnp.exp(gc)[..., None]], axis=-1)
    sol = lax.linalg.triangular_solve(m, rhs, left_side=True, lower=True, unit_diagonal=True)
    u, w = sol[..., :dv], sol[..., dv:]
    qk = jnp.einsum('nbhid,nbhjd->nbhij', qc, kc) * decay
    q_dec = qc * jnp.exp(gc)[..., None]
    g_last = gc[..., -1]
    k_dec = kc * jnp.exp(g_last[..., None] - gc)[..., None]

    def step(state, xs):
        u_n, w_n, q_n, qk_n, k_n, gl_n = xs
        v_new = u_n - jnp.einsum('bhcd,bhde->bhce', w_n, state)
        o = jnp.einsum('bhcd,bhde->bhce', q_n, state) + jnp.einsum('bhij,bhje->bhie', qk_n, v_new)
        state = state * jnp.exp(gl_n)[..., None, None] + jnp.einsum('bhcd,bhce->bhde', k_n, v_new)
        return state, o

    s0 = jnp.zeros((bsz, nh, dk, dv), dtype=u.dtype)
    _, o = lax.scan(step, s0, (u, w, q_dec, qk, k_dec, g_last))
    return o.transpose(1, 0, 3, 2, 4).reshape(bsz, s, nh, dv)


def gdn_group(qkv, z, b, a, conv_w, a_log, dt_bias, out_g):
    bsz, s, _ = qkv.shape
    qkv = jax.nn.silu(causal_depthwise_conv(qkv, conv_w))
    q, k, v = jnp.split(qkv, 3, axis=-1)
    shp = (bsz, s, GDN_HEADS, GDN_HEAD_DIM)
    q = l2norm(q.reshape(shp))
    k = l2norm(k.reshape(shp))
    v = v.reshape(shp)
    beta = jax.nn.sigmoid(b)
    g = -jnp.exp(a_log) * jax.nn.softplus(a + dt_bias)
    o = chunked_gated_delta_rule(q, k, v, beta, g)
    o = rmsnorm(o, out_g) * jax.nn.silu(z.reshape(shp))
    return o.reshape(bsz, s, D_GDN)


def expert_dispatch(xf, expert_id, gate, w_g, w_u, w_d):
    t, d = xf.shape
    n_assign = t * TOP_K
    flat_e = expert_id.reshape(-1)
    order = jnp.argsort(flat_e)
    sorted_e = flat_e[order]
    tok = order // TOP_K
    w_sorted = gate.reshape(-1)[order]
    counts = jax.ops.segment_sum(jnp.ones_like(flat_e), flat_e, num_segments=N_EXPERTS)
    padded = (counts + MOE_BLOCK - 1) // MOE_BLOCK * MOE_BLOCK
    pad_end = jnp.cumsum(padded)
    pad_start = pad_end - padded
    start = jnp.cumsum(counts) - counts
    dest = pad_start[sorted_e] + jnp.arange(n_assign, dtype=sorted_e.dtype) - start[sorted_e]
    n_blocks = -(-n_assign // MOE_BLOCK) + N_EXPERTS
    buf_tok = jnp.full((n_blocks * MOE_BLOCK,), t, dtype=tok.dtype).at[dest].set(tok)
    block_expert = jnp.minimum(
        jnp.searchsorted(pad_end, jnp.arange(n_blocks, dtype=pad_end.dtype) * MOE_BLOCK, side='right'),
        N_EXPERTS - 1)
    xpad = jnp.concatenate([xf, jnp.zeros((1, d), xf.dtype)], axis=0)
    xs = xpad[buf_tok].reshape(n_blocks, MOE_BLOCK, d)

    def expert_block(args):
        xb, e = args
        hb = jax.nn.silu(xb @ w_g[e]) * (xb @ w_u[e])
        return hb @ w_d[e]

    ys = lax.map(expert_block, (xs, block_expert)).reshape(n_blocks * MOE_BLOCK, d)
    return jax.ops.segment_sum(ys[dest] * w_sorted[:, None], tok, num_segments=t)


def hier_moe(xn, w_rg, b_rg, w_re, b_re, w_g, w_u, w_d):
    bsz, s, d = xn.shape
    xf = xn.reshape(bsz * s, d)
    rows = jnp.arange(bsz * s)
    group_logits = (xf @ w_rg + b_rg).astype(jnp.float32)
    g_sel = jnp.argmax(group_logits, axis=-1)
    p_group = jax.nn.softmax(group_logits, axis=-1)[rows, g_sel][:, None]
    e_logits = (xf @ w_re + b_re).astype(jnp.float32).reshape(-1, N_GROUPS, EXPERTS_PER_GROUP)
    in_group = e_logits[rows, g_sel]
    top_p, top_i = lax.top_k(jax.nn.softmax(in_group, axis=-1), TOP_K)
    gate = p_group * top_p / jnp.sum(top_p, axis=-1, keepdims=True)
    expert_id = g_sel[:, None] * EXPERTS_PER_GROUP + top_i
    y = expert_dispatch(xf, expert_id, gate, w_g, w_u, w_d)
    return y.reshape(bsz, s, d)


def setup_inputs(seed: int = 0) -> dict:
    key = jax.random.key(seed)
    ks = jax.random.split(key, 40)
    L = DEPTH

    def nrm(i, shape, scale):
        return jax.random.normal(ks[i], shape, jnp.float32) * scale

    def gain(i, shape):
        return 1.0 + nrm(i, shape, 0.02)

    a0 = jax.random.uniform(ks[10], (L, D_LRU), jnp.float32, 0.9, 0.999)
    s0 = a0 ** (1.0 / LRU_C)
    lru_lambda = jnp.log(s0) - jnp.log1p(-s0)
    gdn_a_log = jnp.log(jax.random.uniform(ks[13], (L, GDN_HEADS), jnp.float32, 1.0, 16.0))
    dt = jnp.exp(jax.random.uniform(ks[14], (L, GDN_HEADS), jnp.float32, float(np.log(1e-3)), float(np.log(1e-1))))
    gdn_dt_bias = dt + jnp.log(-jnp.expm1(-dt))
    return {
        'x': nrm(0, (BATCH, SEQ, D_MODEL), 1.0),
        'p': nrm(1, (L, BATCH, SEQ, D_PLE), 1.0),
        'norm_mix': gain(2, (L, D_MODEL)),
        'w_in': nrm(3, (L, D_MODEL, IN_COLS), D_MODEL ** -0.5),
        'lru_conv_w': nrm(4, (L, CONV_W, D_LRU), CONV_W ** -0.5),
        'lru_conv_b': nrm(5, (L, D_LRU), 0.02),
        'lru_wa': nrm(6, (L, LRU_BLOCKS, LRU_BLOCK_W, LRU_BLOCK_W), LRU_BLOCK_W ** -0.5),
        'lru_ba': nrm(7, (L, D_LRU), 0.02),
        'lru_wi': nrm(8, (L, LRU_BLOCKS, LRU_BLOCK_W, LRU_BLOCK_W), LRU_BLOCK_W ** -0.5),
        'lru_bi': nrm(9, (L, D_LRU), 0.02),
        'lru_lambda': lru_lambda,
        'lru_out_norm': gain(11, (L, D_LRU)),
        'gdn_conv_w': nrm(12, (L, CONV_W, 3 * D_GDN), CONV_W ** -0.5),
        'gdn_a_log': gdn_a_log,
        'gdn_dt_bias': gdn_dt_bias,
        'gdn_out_norm': gain(15, (L, GDN_HEAD_DIM)),
        'w_out': nrm(16, (L, D_MIX, D_MODEL), D_MIX ** -0.5),
        'norm_ffn': gain(17, (L, D_MODEL)),
        'w_router_group': nrm(18, (L, D_MODEL, N_GROUPS), D_MODEL ** -0.5),
        'b_router_group': nrm(19, (L, N_GROUPS), 0.01),
        'w_router_expert': nrm(20, (L, D_MODEL, N_EXPERTS), D_MODEL ** -0.5),
        'b_router_expert': nrm(21, (L, N_EXPERTS), 0.01),
        'w_exp_gate': nrm(22, (L, N_EXPERTS, D_MODEL, D_EXPERT), D_MODEL ** -0.5),
        'w_exp_up': nrm(23, (L, N_EXPERTS, D_MODEL, D_EXPERT), D_MODEL ** -0.5),
        'w_exp_down': nrm(24, (L, N_EXPERTS, D_EXPERT, D_MODEL), D_EXPERT ** -0.5),
        'norm_ple': gain(25, (L, D_MODEL)),
        'w_ple_gate': nrm(26, (L, D_MODEL, D_MODEL), D_MODEL ** -0.5),
        'w_ple': nrm(27, (L, D_PLE, D_MODEL), D_PLE ** -0.5),
        'norm_final': gain(28, (D_MODEL,)),
    }


def reference(x, p, norm_mix, w_in, lru_conv_w, lru_conv_b, lru_wa, lru_ba, lru_wi, lru_bi, lru_lambda,
              lru_out_norm, gdn_conv_w, gdn_a_log, gdn_dt_bias, gdn_out_norm, w_out, norm_ffn,
              w_router_group, b_router_group, w_router_expert, b_router_expert, w_exp_gate, w_exp_up,
              w_exp_down, norm_ple, w_ple_gate, w_ple, norm_final):
    h = x.astype(jnp.float32)
    o_gate = D_LRU
    o_qkv = 2 * D_LRU
    o_z = o_qkv + 3 * D_GDN
    o_beta = o_z + D_GDN
    o_alpha = o_beta + GDN_HEADS
    for l in range(DEPTH):
        xn = rmsnorm(h, norm_mix[l])
        proj = xn @ w_in[l]
        y_lru = rglru_group(proj[..., :o_gate], proj[..., o_gate:o_qkv], lru_conv_w[l], lru_conv_b[l],
                            lru_wa[l], lru_ba[l], lru_wi[l], lru_bi[l], lru_lambda[l], lru_out_norm[l])
        y_gdn = gdn_group(proj[..., o_qkv:o_z], proj[..., o_z:o_beta], proj[..., o_beta:o_alpha],
                          proj[..., o_alpha:], gdn_conv_w[l], gdn_a_log[l], gdn_dt_bias[l], gdn_out_norm[l])
        h = h + jnp.concatenate([y_lru, y_gdn], axis=-1) @ w_out[l]
        h = h + hier_moe(rmsnorm(h, norm_ffn[l]), w_router_group[l], b_router_group[l], w_router_expert[l],
                         b_router_expert[l], w_exp_gate[l], w_exp_up[l], w_exp_down[l])
        gate = jax.nn.sigmoid(rmsnorm(h, norm_ple[l]) @ w_ple_gate[l])
        h = h + (p[l].astype(jnp.float32) @ w_ple[l]) * gate
    return rmsnorm(h, norm_final).astype(x.dtype)
```

```cpp
#include <hip/hip_runtime.h>
#include <hip/hip_cooperative_groups.h>
#include <cstdio>
#include <cstdint>
namespace cg = cooperative_groups;
namespace pg8 {
#define PG8_LAS __attribute__((address_space(3)))
typedef unsigned short bf16_t;
typedef short bf16x8 __attribute__((ext_vector_type(8)));
typedef float f32x4 __attribute__((ext_vector_type(4)));
typedef unsigned u32x4 __attribute__((ext_vector_type(4)));
constexpr int BM = 256, BK = 64, HALF = 128, HTB = HALF * BK * 2  , STAGE_BYTES = 8 * HTB, NXCD = 8, WGM = 8;

__host__ __device__ __forceinline__ int lds_byte(int r, int c) { const int st = (r >> 4) * 2 + (c >> 5), rr = r & 15, cc = c & 31, ob = rr * 64 + cc * 2; return st * 1024 + (ob ^ (((ob >> 9) & 1) << 5)); }
__host__ __device__ __forceinline__ void stage_rc(int b, int& R, int& C) { const int st = b / 1024, sb = b % 1024, swz = sb ^ (((sb >> 9) & 1) << 5); R = (st >> 1) * 16 + swz / 64; C = (st & 1) * 32 + (swz % 64) / 2; }
__host__ __device__ __forceinline__ int perm32(int rho) { const int n = rho >> 4, i = rho & 15; return 8 * (i >> 2) + 4 * n + (i & 3); }

struct Unit { int pm, pn; };
struct Gemm { const bf16_t* A; const bf16_t* Bt; int M, N, K; };

struct StaticOrder {
    int nM, nN, nwg, G, c;
    __host__ __device__ void init(int M, int N, int G_, int c_) { nM = M / BM; nN = N / BM; nwg = nM * nN; G = G_; c = c_; }
    __host__ __device__ bool next(int i, Unit& u) const {
        const long L = (long)i * G + c; if (L >= nwg) return false;
        int wgid = (int)L; { const int q = nwg / NXCD, r = nwg % NXCD, xcd = wgid % NXCD, off = wgid / NXCD; wgid = (xcd < r ? xcd * (q + 1) : r * (q + 1) + (xcd - r) * q) + off; }
        const int nig = WGM * nN, gid = wgid / nig, fm = gid * WGM, gsz = (nM - fm) < WGM ? (nM - fm) : WGM;
        u.pm = fm + ((wgid % nig) % gsz); u.pn = (wgid % nig) / gsz; return true;
    }
    __device__ __forceinline__ void a_ready(const Unit&) const {}
    __device__ __forceinline__ void done(const Unit&) const {}
};

__device__ __forceinline__ unsigned cvt_pk_bf16(float lo, float hi) { unsigned r; asm volatile("v_cvt_pk_bf16_f32 %0, %1, %2" : "=v"(r) : "v"(lo), "v"(hi)); return r; }
typedef float f32x2 __attribute__((ext_vector_type(2)));
__device__ __forceinline__ f32x2 gelu_pk(f32x2 v) {
    const f32x2 av = __builtin_elementwise_abs(v), d = av * 0.2316418882f + 1.0f;
    f32x2 t; t.x = __builtin_amdgcn_rcpf(d.x); t.y = __builtin_amdgcn_rcpf(d.y);
    f32x2 q = t * 0.5307027145f + (-0.7265760135f); q = q * t + 0.7107068705f; q = q * t + (-0.142248368f); q = q * t + 0.127414796f; q = q * t;
    const f32x2 s = (v * v) * (-0.72134752044f);
    f32x2 e; e.x = __builtin_amdgcn_exp2f(s.x); e.y = __builtin_amdgcn_exp2f(s.y);
    const f32x2 m = v * (q * e), r = v - m;
    f32x2 o; o.x = v.x < 0.f ? m.x : r.x; o.y = v.y < 0.f ? m.y : r.y; return o;
}

template <int ACT  > struct EpiBf16 {
    static constexpr bool PERM = true, AFTER_DRAIN = false; static_assert(ACT == 0 || ACT == 1, "EpiBf16: ACT is 0 (none) or 1 (gelu_pk)");
    bf16_t* O; int ldc; const float* bias; int split_cols; size_t split_stride; float scale0;
    __device__ __forceinline__ void operator()(const f32x4 (&acc)[2][2][4][2], const Unit& u, int wr, int wc, int fr, int fq) const {
        const int row0 = u.pm * BM + wr * 64 + fr; int colt = u.pn * BM; bf16_t* base = O;
        float sc = 1.f; if (split_cols) { const int t = colt / split_cols; base += (size_t)t * split_stride; colt -= t * split_cols; if (t == 0) sc = scale0; }
        const int col0 = colt + wc * 32 + 8 * fq, bcol0 = u.pn * BM + wc * 32 + 8 * fq;
        f32x4 bv[2][2];
#pragma unroll
        for (int bj = 0; bj < 2; ++bj)
#pragma unroll
            for (int n = 0; n < 2; ++n) bv[bj][n] = bias ? *(const f32x4*)(bias + bcol0 + bj * HALF + 4 * n) : (f32x4){0.f, 0.f, 0.f, 0.f};
#pragma unroll
        for (int ai = 0; ai < 2; ++ai)
#pragma unroll
            for (int m = 0; m < 4; ++m) { bf16_t* rowp = base + (size_t)(row0 + ai * HALF + m * 16) * ldc + col0;
#pragma unroll
                for (int bj = 0; bj < 2; ++bj) { f32x4 v0 = acc[ai][bj][m][0] + bv[bj][0], v1 = acc[ai][bj][m][1] + bv[bj][1];
                    if (ACT == 1) { f32x2 a = gelu_pk((f32x2){v0[0], v0[1]}), b = gelu_pk((f32x2){v0[2], v0[3]}), c = gelu_pk((f32x2){v1[0], v1[1]}), d = gelu_pk((f32x2){v1[2], v1[3]});
                        v0 = (f32x4){a.x, a.y, b.x, b.y}; v1 = (f32x4){c.x, c.y, d.x, d.y}; }
                    v0 = v0 * sc; v1 = v1 * sc; u32x4 w; w.x = cvt_pk_bf16(v0[0], v0[1]); w.y = cvt_pk_bf16(v0[2], v0[3]); w.z = cvt_pk_bf16(v1[0], v1[1]); w.w = cvt_pk_bf16(v1[2], v1[3]);
                    *(u32x4*)(rowp + bj * HALF) = w; } }
    }
};
template <class Epi, class Sched, bool ALIGN_EPI = false, bool SP2 = false>
__device__ __forceinline__ void gemm_phase(PG8_LAS unsigned char* lds, const Gemm g, const Sched& S, const Epi& E) {
    const int tid = threadIdx.x, wid = __builtin_amdgcn_readfirstlane(tid >> 6), lane = tid & 63, wr = wid >> 2, wc = wid & 3, fr = lane & 15, fq = lane >> 4;
    const int K = g.K, nt = K / BK;
    unsigned voffA[2], voffB[2];
#pragma unroll
    for (int i = 0; i < 2; ++i) { int R, C; stage_rc(tid * 16 + i * 8192, R, C); const int Rb = Epi::PERM ? ((R & ~31) + perm32(R & 31)) : R;
        voffA[i] = (unsigned)(R * K + C) * 2u; voffB[i] = (unsigned)(Rb * K + C) * 2u; }
    const size_t kstep = (size_t)(BK * 2);
    const size_t hstep = (size_t)HALF * K * 2;
    const size_t tstep = 2 * hstep;
    const unsigned ldsw = (unsigned)wid * 1024u;
    const int aoff = lds_byte(wr * 64 + fr, fq * 8), boff = lds_byte(wc * 32 + fr, fq * 8);
#define PG8_SA(b, h) (((b) * 2 + (h)) * HTB)
#define PG8_SB(b, h) ((4 + (b) * 2 + (h)) * HTB)
#define PG8_STAGE(bufoff, gbase, voff) do { _Pragma("unroll") for (int _i = 0; _i < 2; ++_i) \
        __builtin_amdgcn_global_load_lds((const unsigned*)((const char*)(gbase) + (voff)[_i]), (PG8_LAS unsigned*)(lds + (bufoff) + ldsw + _i * 8192), 16, 0, 0); } while (0)
#define PG8_LDA(dst, b, h) do { _Pragma("unroll") for (int m = 0; m < 4; ++m) _Pragma("unroll") for (int k = 0; k < 2; ++k) dst[m][k] = *(const PG8_LAS bf16x8*)(lds + PG8_SA(b, h) + aoff + m * 2048 + k * 1024); } while (0)
#define PG8_LDB(dst, b, h) do { _Pragma("unroll") for (int n = 0; n < 2; ++n) _Pragma("unroll") for (int k = 0; k < 2; ++k) dst[n][k] = *(const PG8_LAS bf16x8*)(lds + PG8_SB(b, h) + boff + n * 2048 + k * 1024); } while (0)
#define PG8_MMA(ai, bj, At, Bt) do { __builtin_amdgcn_s_setprio(1); _Pragma("unroll") for (int m = 0; m < 4; ++m) _Pragma("unroll") for (int n = 0; n < 2; ++n) _Pragma("unroll") for (int k = 0; k < 2; ++k) \
        acc[ai][bj][m][n] = __builtin_amdgcn_mfma_f32_16x16x32_bf16(Bt[n][k], At[m][k], acc[ai][bj][m][n], 0, 0, 0); __builtin_amdgcn_s_setprio(0); } while (0)
#define PG8_WAIT_V(n) asm volatile("s_waitcnt vmcnt(" #n ")" ::: "memory")
#define PG8_WAIT_L(n) asm volatile("s_waitcnt lgkmcnt(" #n ")" ::: "memory")
#define PG8_BAR __builtin_amdgcn_s_barrier()
#define PG8_SCHED __builtin_amdgcn_sched_barrier(0)
    Unit cur, nxt; int ui = 0;
    if (!S.next(0, cur)) return;
    f32x4 acc[2][2][4][2];
#pragma unroll
    for (int a = 0; a < 2; ++a)
#pragma unroll
        for (int b = 0; b < 2; ++b)
#pragma unroll
            for (int m = 0; m < 4; ++m)
#pragma unroll
                for (int n = 0; n < 2; ++n) acc[a][b][m][n] = (f32x4){0.f, 0.f, 0.f, 0.f};
    bf16x8 At[4][2], B0[2][2], B1[2][2];
    const char* cA = (const char*)g.A + (size_t)cur.pm * tstep; const char* cB = (const char*)g.Bt + (size_t)cur.pn * tstep;
    S.a_ready(cur);
    if constexpr (SP2) {
        PG8_STAGE(PG8_SB(0, 0), cB, voffB); PG8_STAGE(PG8_SB(0, 1), cB + hstep, voffB); PG8_STAGE(PG8_SA(0, 0), cA, voffA); PG8_STAGE(PG8_SA(0, 1), cA + hstep, voffA);
        if (wr == 1) PG8_BAR;
        PG8_WAIT_V(2); PG8_BAR;
        PG8_STAGE(PG8_SB(1, 0), cB + kstep, voffB); PG8_STAGE(PG8_SA(1, 0), cA + kstep, voffA); PG8_STAGE(PG8_SB(1, 1), cB + hstep + kstep, voffB);
        PG8_WAIT_V(6); PG8_BAR;
    } else {
        PG8_STAGE(PG8_SB(0, 0), cB, voffB); PG8_STAGE(PG8_SA(0, 0), cA, voffA); PG8_STAGE(PG8_SB(0, 1), cB + hstep, voffB); PG8_STAGE(PG8_SA(0, 1), cA + hstep, voffA);
        if (wr == 1) PG8_BAR;
        PG8_WAIT_V(4); PG8_BAR;
        PG8_STAGE(PG8_SB(1, 0), cB + kstep, voffB); PG8_STAGE(PG8_SA(1, 0), cA + kstep, voffA); PG8_STAGE(PG8_SB(1, 1), cB + hstep + kstep, voffB);
        PG8_WAIT_V(6); PG8_BAR;
    }
    for (;;) {
        const bool has_next = S.next(ui + 1, nxt);
        const char* nA = has_next ? (const char*)g.A + (size_t)nxt.pm * tstep : cA; const char* nB = has_next ? (const char*)g.Bt + (size_t)nxt.pn * tstep : cB;
        for (int t = 0; t < nt; t += 2) {
            const bool last = (t == nt - 2);
            const char* a1 = cA + (size_t)(t + 1) * kstep;
            const char* a2 = last ? nA : cA + (size_t)(t + 2) * kstep; const char* b2 = last ? nB : cB + (size_t)(t + 2) * kstep;
            const char* a3 = a2 + kstep; const char* b3 = b2 + kstep;
            if (last && has_next) S.a_ready(nxt);
            if constexpr (SP2) {
            PG8_LDB(B0, 0, 0); PG8_LDB(B1, 0, 1); PG8_SCHED; PG8_LDA(At, 0, 0); PG8_STAGE(PG8_SA(1, 1), a1 + hstep, voffA);
            PG8_WAIT_V(8); PG8_WAIT_L(0); PG8_BAR; PG8_MMA(0, 0, At, B0); PG8_MMA(0, 1, At, B1); PG8_BAR; PG8_SCHED;
            PG8_LDA(At, 0, 1); PG8_STAGE(PG8_SB(0, 0), b2, voffB); PG8_STAGE(PG8_SB(0, 1), b2 + hstep, voffB); PG8_STAGE(PG8_SA(0, 0), a2, voffA);
            PG8_WAIT_V(8); PG8_WAIT_L(0); PG8_BAR; PG8_MMA(1, 0, At, B0); PG8_MMA(1, 1, At, B1); PG8_BAR; PG8_SCHED;
            PG8_LDB(B0, 1, 0); PG8_LDB(B1, 1, 1); PG8_SCHED; PG8_LDA(At, 1, 0); PG8_STAGE(PG8_SA(0, 1), a2 + hstep, voffA);
            PG8_WAIT_V(8); PG8_WAIT_L(0); PG8_BAR; PG8_MMA(0, 0, At, B0); PG8_MMA(0, 1, At, B1); PG8_BAR; PG8_SCHED;
            PG8_LDA(At, 1, 1); PG8_STAGE(PG8_SB(1, 0), b3, voffB); PG8_STAGE(PG8_SB(1, 1), b3 + hstep, voffB); PG8_STAGE(PG8_SA(1, 0), a3, voffA);
            PG8_WAIT_V(8); PG8_WAIT_L(0); PG8_BAR; PG8_MMA(1, 0, At, B0); PG8_MMA(1, 1, At, B1); PG8_BAR; PG8_SCHED;
            } else {
            PG8_LDB(B0, 0, 0); PG8_SCHED; PG8_LDA(At, 0, 0); PG8_STAGE(PG8_SA(1, 1), a1 + hstep, voffA);
            PG8_WAIT_L(8); PG8_BAR; PG8_WAIT_L(0); PG8_MMA(0, 0, At, B0); PG8_BAR; PG8_SCHED;
            PG8_LDB(B1, 0, 1); PG8_STAGE(PG8_SB(0, 0), b2, voffB);
            PG8_BAR; PG8_WAIT_L(0); PG8_MMA(0, 1, At, B1); PG8_BAR;
            PG8_LDA(At, 0, 1); PG8_STAGE(PG8_SA(0, 0), a2, voffA);
            PG8_BAR; PG8_WAIT_L(0); PG8_MMA(1, 0, At, B0); PG8_BAR; PG8_SCHED;
            PG8_STAGE(PG8_SB(0, 1), b2 + hstep, voffB);
            PG8_WAIT_V(6); PG8_BAR; PG8_MMA(1, 1, At, B1); PG8_BAR;
            PG8_LDB(B0, 1, 0); PG8_SCHED; PG8_LDA(At, 1, 0); PG8_STAGE(PG8_SA(0, 1), a2 + hstep, voffA);
            PG8_WAIT_L(8); PG8_BAR; PG8_WAIT_L(0); PG8_MMA(0, 0, At, B0); PG8_BAR; PG8_SCHED;
            PG8_LDB(B1, 1, 1); PG8_STAGE(PG8_SB(1, 0), b3, voffB);
            PG8_BAR; PG8_WAIT_L(0); PG8_MMA(0, 1, At, B1); PG8_BAR;
            PG8_LDA(At, 1, 1); PG8_STAGE(PG8_SA(1, 0), a3, voffA);
            PG8_BAR; PG8_WAIT_L(0); PG8_MMA(1, 0, At, B0); PG8_BAR; PG8_SCHED;
            PG8_STAGE(PG8_SB(1, 1), b3 + hstep, voffB);
            PG8_WAIT_V(6); PG8_BAR; PG8_MMA(1, 1, At, B1); PG8_BAR;
            }
        }
        if constexpr (ALIGN_EPI) { if (wr == 0) PG8_BAR; }
        if constexpr (!Epi::AFTER_DRAIN) { E(acc, cur, wr, wc, fr, fq); S.done(cur); }
        if (!has_next) break;
#pragma unroll
        for (int a = 0; a < 2; ++a)
#pragma unroll
            for (int b = 0; b < 2; ++b)
#pragma unroll
                for (int m = 0; m < 4; ++m)
#pragma unroll
                    for (int n = 0; n < 2; ++n) acc[a][b][m][n] = (f32x4){0.f, 0.f, 0.f, 0.f};
        cur = nxt; cA = nA; cB = nB; ++ui;
        if constexpr (ALIGN_EPI) { if (wr == 1) PG8_BAR; }
    }
    PG8_WAIT_V(0);
    if constexpr (!ALIGN_EPI) { if (wr == 0) PG8_BAR; }
    PG8_BAR;
    if constexpr (Epi::AFTER_DRAIN) { E.fused(acc, cur, wr, wc, fr, fq, lds, wid, lane); S.done(cur); }
#undef PG8_SA
#undef PG8_SB
#undef PG8_STAGE
#undef PG8_LDA
#undef PG8_LDB
#undef PG8_MMA
#undef PG8_WAIT_V
#undef PG8_WAIT_L
#undef PG8_BAR
#undef PG8_SCHED
}
}

#ifndef DBG
#define DBG 0
#endif
#define DI __device__ __forceinline__
#define LAS __attribute__((address_space(3)))
typedef unsigned short bf16;
typedef unsigned v4u __attribute__((ext_vector_type(4)));
typedef unsigned v2u __attribute__((ext_vector_type(2)));
typedef float f32x4 __attribute__((ext_vector_type(4)));
typedef float f32x2 __attribute__((ext_vector_type(2)));
typedef float f32x16 __attribute__((ext_vector_type(16)));
typedef short bf16x8 __attribute__((ext_vector_type(8)));
typedef __bf16 bfv2 __attribute__((ext_vector_type(2)));

constexpr int T = 32768, DM = 1024, SEQ = 4096, NB = 8, DPLE = 256;
constexpr int INC = 3080;
constexpr float EPS = 1e-6f;
constexpr size_t MiB = 1u << 20;
constexpr size_t WS_CTL = 0;
constexpr size_t WS_WAIF = 1 * MiB;
constexpr size_t WS_WRT = 1 * MiB + 256 * 1024;
constexpr size_t WS_BA = 2 * MiB;
constexpr size_t WS_SUM = 3 * MiB;
constexpr size_t WS_GL = 5 * MiB;
constexpr size_t WS_DBGBUF = 5 * MiB + 64 * 1024;
constexpr size_t WS_TOK = 6 * MiB;
constexpr size_t WS_SLOTG = 7 * MiB;
constexpr size_t WS_TILE = 7 * MiB + 512 * 1024;
constexpr size_t WS_WINT = 8 * MiB, WS_WOUTT = 14 * MiB, WS_WPGT = 16 * MiB, WS_WPT = 18 * MiB;
constexpr size_t WS_PB = 20 * MiB;
constexpr size_t WS_XN1 = 36 * MiB, WS_Y = 36 * MiB, WS_WDT = 36 * MiB, WS_XN3 = 36 * MiB;
constexpr size_t WS_PROJ = 100 * MiB;
constexpr size_t WS_H1 = 100 * MiB;
constexpr size_t WS_WGUT = 228 * MiB, WS_PE = 228 * MiB;
constexpr size_t WS_GOP = 292 * MiB, WS_XS = 292 * MiB, WS_YB = 292 * MiB;
constexpr size_t WS_O = 436 * MiB, WS_XN2 = 436 * MiB, WS_HB = 436 * MiB;
constexpr size_t WS_END = 508 * MiB;
constexpr int GOP_ITEM = 73728;
constexpr int LDS_BYTES = 147456;

#define LDS_WAIT() asm volatile("s_waitcnt lgkmcnt(0)" ::: "memory")
DI unsigned pk2(float lo, float hi) { bfv2 v; v[0] = (__bf16)lo; v[1] = (__bf16)hi; return __builtin_bit_cast(unsigned, v); }
DI float bf_lo(unsigned u) { return __uint_as_float(u << 16); }
DI float bf_hi(unsigned u) { return __uint_as_float(u & 0xffff0000u); }
DI float bf2f(bf16 b) { return __uint_as_float(((unsigned)b) << 16); }
DI bf16 f2bf(float f) { return (bf16)(pk2(f, 0.f) & 0xffffu); }
DI float wave_sum(float v) {
#pragma unroll
    for (int o = 1; o < 64; o <<= 1) v += __shfl_xor(v, o);
    return v;
}
DI float sigmoidf_(float x) { return 1.f / (1.f + __expf(-x)); }
DI float siluf_(float x) { return x / (1.f + __expf(-x)); }
DI float geluf_(float x) { const float u = 1.5957691216f * (x + 0.044715f * x * x * x); return x / (1.f + __expf(-u)); }
DI unsigned ld_u32(const unsigned* p) { return __hip_atomic_load(p, __ATOMIC_RELAXED, __HIP_MEMORY_SCOPE_AGENT); }
DI float ld_f32(const float* p) { return __uint_as_float(__hip_atomic_load((const unsigned*)p, __ATOMIC_RELAXED, __HIP_MEMORY_SCOPE_AGENT)); }
#define MFMA16(a, b, c) __builtin_amdgcn_mfma_f32_16x16x32_bf16((a), (b), (c), 0, 0, 0)
#define MFMA32(a, b, c) __builtin_amdgcn_mfma_f32_32x32x16_bf16((a), (b), (c), 0, 0, 0)
DI bf16x8 pack8(const float* a) { v4u p; p.x = pk2(a[0], a[1]); p.y = pk2(a[2], a[3]); p.z = pk2(a[4], a[5]); p.w = pk2(a[6], a[7]); return __builtin_bit_cast(bf16x8, p); }
template <int S_> DI bf16x8 pack_step(const f32x16& x) { v4u p; p.x = pk2(x[8 * S_ + 0], x[8 * S_ + 1]); p.y = pk2(x[8 * S_ + 2], x[8 * S_ + 3]); p.z = pk2(x[8 * S_ + 4], x[8 * S_ + 5]); p.w = pk2(x[8 * S_ + 6], x[8 * S_ + 7]); return __builtin_bit_cast(bf16x8, p); }

struct Params { const float* in[29]; float* out; unsigned char* ws; int ph_lo, ph_hi; };

DI void transpose_item(const float* __restrict__ W, int ldw, const float* __restrict__ gain, bf16* WT, int ldt, int dst_row0, int k0, int n0, LAS float* scr, int lane) {
#pragma unroll 8
    for (int i = 0; i < 32; ++i) { const int kk = 2 * i + (lane >> 5); const float g = gain ? gain[k0 + kk] : 1.f;
        scr[kk * 33 + (lane & 31)] = W[(size_t)(k0 + kk) * ldw + n0 + (lane & 31)] * g; }
    LDS_WAIT(); asm volatile("" ::: "memory");
    const int c = lane & 7;
#pragma unroll
    for (int j = 0; j < 4; ++j) { const int n = (lane >> 3) + 8 * j; const LAS float* s = scr + (8 * c) * 33 + n;
        v4u o; o.x = pk2(s[0 * 33], s[1 * 33]); o.y = pk2(s[2 * 33], s[3 * 33]); o.z = pk2(s[4 * 33], s[5 * 33]); o.w = pk2(s[6 * 33], s[7 * 33]);
        *(v4u*)(WT + (size_t)(dst_row0 + n) * ldt + k0 + 8 * c) = o; }
    LDS_WAIT(); asm volatile("" ::: "memory");
}

DI void phase0(const Params& P, LAS unsigned char* lds, int tid, int lane, int wid, int gw, int NGW) {
    unsigned char* ws = P.ws;
    const float* x = P.in[0]; const float* p = P.in[1]; const float* norm_mix = P.in[2]; const float* w_in = P.in[3];
    LAS float* scr = (LAS float*)(lds + wid * 8448);
    LAS float* Wba = (LAS float*)(lds + 73728);
    for (int e = tid; e < 8192; e += 512) { const int k = e >> 3, j = e & 7; Wba[e] = w_in[(size_t)k * INC + 3072 + j] * norm_mix[k]; }
    for (int it = gw; it < 2688; it += NGW) {
        int r = it;
        if (r < 1536) { const int kb = r / 96, nb = r % 96; transpose_item(w_in, INC, norm_mix, (bf16*)(ws + WS_WINT), 1024, 32 * nb, 64 * kb, 32 * nb, scr, lane); continue; } r -= 1536;
        if (r < 512) { const int kb = r >> 5, nb = r & 31; transpose_item(P.in[16], 1024, nullptr, (bf16*)(ws + WS_WOUTT), 1024, 32 * nb, 64 * kb, 32 * nb, scr, lane); continue; } r -= 512;
        if (r < 512) { const int kb = r >> 5, nb = r & 31; transpose_item(P.in[26], 1024, P.in[25], (bf16*)(ws + WS_WPGT), 1024, 32 * nb, 64 * kb, 32 * nb, scr, lane); continue; } r -= 512;
        { const int kb = r >> 5, nb = r & 31; transpose_item(P.in[27], 1024, nullptr, (bf16*)(ws + WS_WPT), 256, 32 * nb, 64 * kb, 32 * nb, scr, lane); }
    }
    { bf16* WAIF = (bf16*)(ws + WS_WAIF); const float* wa = P.in[6]; const float* wi = P.in[8];
      for (int e = gw * 64 + lane; e < 65536; e += NGW * 64) { const int j = e & 7, ln = (e >> 3) & 63, kk = (e >> 9) & 1, nt = (e >> 10) & 7, cb = e >> 13;
          const int fr = ln & 15, fq = ln >> 4, c = 32 * kk + 8 * fq + j, d = 16 * (nt & 3) + fr;
          WAIF[e] = f2bf((nt < 4 ? wa : wi)[(cb * 64 + c) * 64 + d]); } }
    { float* WRT = (float*)(ws + WS_WRT); const float* nf = P.in[17]; const float* wrg = P.in[18]; const float* wre = P.in[20];
      for (int e = gw * 64 + lane; e < 36 * 1024; e += NGW * 64) { const int c = e >> 10, k = e & 1023; WRT[e] = (c < 4 ? wrg[k * 4 + c] : wre[k * 32 + (c - 4)]) * nf[k]; } }
    { const f32x4* p4 = (const f32x4*)p; v4u* pb = (v4u*)(ws + WS_PB);
      for (int i = gw * 64 + lane; i < T * DPLE / 8; i += NGW * 64) { const f32x4 a = p4[2 * i], b = p4[2 * i + 1]; v4u o; o.x = pk2(a.x, a.y); o.y = pk2(a.z, a.w); o.z = pk2(b.x, b.y); o.w = pk2(b.z, b.w); pb[i] = o; } }
    __syncthreads();
    { bf16* XN1 = (bf16*)(ws + WS_XN1); float* BA = (float*)(ws + WS_BA);
      for (int t = gw; t < T; t += NGW) {
          const f32x4* xr = (const f32x4*)(x + (size_t)t * DM);
          f32x4 v[4]; float ss = 0.f;
#pragma unroll
          for (int j = 0; j < 4; ++j) { v[j] = xr[lane + 64 * j]; ss += (v[j].x * v[j].x + v[j].y * v[j].y) + (v[j].z * v[j].z + v[j].w * v[j].w); }
          const float rs = rsqrtf(wave_sum(ss) * (1.f / DM) + EPS);
          float acc[8];
#pragma unroll
          for (int c = 0; c < 8; ++c) acc[c] = 0.f;
#pragma unroll
          for (int j = 0; j < 4; ++j) {
              const int k4 = 4 * (lane + 64 * j);
              *(v2u*)(XN1 + (size_t)t * DM + k4) = (v2u){pk2(v[j].x * rs, v[j].y * rs), pk2(v[j].z * rs, v[j].w * rs)};
#pragma unroll
              for (int e = 0; e < 4; ++e) { const f32x4 w0 = *(const LAS f32x4*)(Wba + (k4 + e) * 8), w1 = *(const LAS f32x4*)(Wba + (k4 + e) * 8 + 4); const float xv = v[j][e];
                  acc[0] += xv * w0.x; acc[1] += xv * w0.y; acc[2] += xv * w0.z; acc[3] += xv * w0.w; acc[4] += xv * w1.x; acc[5] += xv * w1.y; acc[6] += xv * w1.z; acc[7] += xv * w1.w; }
          }
#pragma unroll
          for (int c = 0; c < 8; ++c) acc[c] = wave_sum(acc[c]) * rs;
          if (lane == 0) { *(f32x4*)(BA + (size_t)t * 8) = (f32x4){acc[0], acc[1], acc[2], acc[3]}; *(f32x4*)(BA + (size_t)t * 8 + 4) = (f32x4){acc[4], acc[5], acc[6], acc[7]}; }
      } }
    __syncthreads();
}

struct EpiRes {
    static constexpr bool PERM = false, AFTER_DRAIN = false;
    float* C; const float* R;
    DI void operator()(const pg8::f32x4 (&acc)[2][2][4][2], const pg8::Unit& u, int wr, int wc, int fr, int fq) const {
        const int row0 = u.pm * 256 + wr * 64 + fr, col0 = u.pn * 256 + wc * 32 + 4 * fq;
#pragma unroll
        for (int ai = 0; ai < 2; ++ai)
#pragma unroll
            for (int m = 0; m < 4; ++m) { const size_t off = (size_t)(row0 + ai * 128 + m * 16) * DM + col0;
#pragma unroll
                for (int bj = 0; bj < 2; ++bj)
#pragma unroll
                    for (int n = 0; n < 2; ++n) { const size_t o = off + bj * 128 + n * 16; *(f32x4*)(C + o) = acc[ai][bj][m][n] + *(const f32x4*)(R + o); } }
    }
};
struct EpiSwiglu {
    static constexpr bool PERM = true, AFTER_DRAIN = false;
    bf16* HB;
    DI void operator()(const pg8::f32x4 (&acc)[2][2][4][2], const pg8::Unit& u, int wr, int wc, int fr, int fq) const {
        const int row0 = u.pm * 256 + wr * 64 + fr, colh = (u.pn & 3) * 128 + wc * 32 + 8 * fq;
#pragma unroll
        for (int ai = 0; ai < 2; ++ai)
#pragma unroll
            for (int m = 0; m < 4; ++m) { bf16* rowp = HB + (size_t)(row0 + ai * 128 + m * 16) * 512 + colh;
                float v[8];
#pragma unroll
                for (int n = 0; n < 2; ++n)
#pragma unroll
                    for (int e = 0; e < 4; ++e) { const float g = acc[ai][0][m][n][e], up = acc[ai][1][m][n][e]; v[4 * n + e] = siluf_(g) * up; }
                v4u w; w.x = pk2(v[0], v[1]); w.y = pk2(v[2], v[3]); w.z = pk2(v[4], v[5]); w.w = pk2(v[6], v[7]);
                *(v4u*)rowp = w; }
    }
};
struct EpiDown {
    static constexpr bool PERM = true, AFTER_DRAIN = false;
    bf16* YB; const float* slotg;
    DI void operator()(const pg8::f32x4 (&acc)[2][2][4][2], const pg8::Unit& u, int wr, int wc, int fr, int fq) const {
        const int row0 = u.pm * 256 + wr * 64 + fr, col0 = (u.pn & 3) * 256 + wc * 32 + 8 * fq;
#pragma unroll
        for (int ai = 0; ai < 2; ++ai)
#pragma unroll
            for (int m = 0; m < 4; ++m) { const int row = row0 + ai * 128 + m * 16; const float gwt = slotg[row]; bf16* rowp = YB + (size_t)row * DM + col0;
#pragma unroll
                for (int bj = 0; bj < 2; ++bj) { const pg8::f32x4 v0 = acc[ai][bj][m][0] * gwt, v1 = acc[ai][bj][m][1] * gwt;
                    v4u w; w.x = pk2(v0[0], v0[1]); w.y = pk2(v0[2], v0[3]); w.z = pk2(v1[0], v1[1]); w.w = pk2(v1[2], v1[3]);
                    *(v4u*)(rowp + bj * 128) = w; } }
    }
};
struct EpiPle {
    static constexpr bool PERM = false, AFTER_DRAIN = false;
    float* H; const bf16* PE; float* RS4;
    DI void operator()(const pg8::f32x4 (&acc)[2][2][4][2], const pg8::Unit& u, int wr, int wc, int fr, int fq) const {
        const int row0 = u.pm * 256 + wr * 64 + fr, col0 = u.pn * 256 + wc * 32 + 4 * fq;
#pragma unroll
        for (int ai = 0; ai < 2; ++ai)
#pragma unroll
            for (int m = 0; m < 4; ++m) { const int row = row0 + ai * 128 + m * 16; const size_t off = (size_t)row * DM + col0; float ss = 0.f;
#pragma unroll
                for (int bj = 0; bj < 2; ++bj)
#pragma unroll
                    for (int n = 0; n < 2; ++n) { const size_t o = off + bj * 128 + n * 16; const f32x4 h2 = *(const f32x4*)(H + o); const v2u pe = *(const v2u*)(PE + o);
                        const pg8::f32x4 a = acc[ai][bj][m][n]; f32x4 h3;
                        h3.x = h2.x + bf_lo(pe.x) * sigmoidf_(a[0]); h3.y = h2.y + bf_hi(pe.x) * sigmoidf_(a[1]); h3.z = h2.z + bf_lo(pe.y) * sigmoidf_(a[2]); h3.w = h2.w + bf_hi(pe.y) * sigmoidf_(a[3]);
                        *(f32x4*)(H + o) = h3; ss += (h3.x * h3.x + h3.y * h3.y) + (h3.z * h3.z + h3.w * h3.w); }
                ss += __shfl_xor(ss, 16); ss += __shfl_xor(ss, 32);
                if (fq == 0) atomicAdd(RS4 + row, ss); }
    }
};
struct MoeSched {
    const unsigned* tile_e; int nU, G, c;
    DI bool next(int i, pg8::Unit& u) const { const int L = i * G + c; if (L >= nU) return false; const int pm = L >> 2;
        u.pm = pm; u.pn = (int)__builtin_amdgcn_readfirstlane(ld_u32(tile_e + pm)) * 4 + (L & 3); return true; }
    DI void a_ready(const pg8::Unit&) const {}
    DI void done(const pg8::Unit&) const {}
};

template <bool PASS2>
DI void lru_item(int bi, const bf16* LX, const bf16* LG, const float* conv_w, const float* conv_b, const bf16* WAIF, const float* ba, const float* bi_, const float* lam,
                 const float* out_g, float* SUM, bf16* Y, LAS unsigned char* lds, int tid, int lane, int wid) {
    asm volatile("" : "+v"(lane), "+v"(tid));
    const int n = bi & 63, b = bi >> 6, t0 = b * SEQ + 64 * n;
    LAS bf16* XT = (LAS bf16*)lds; LAS float* CW = (LAS float*)(lds + 69696); LAS float* PART = (LAS float*)(lds + 79936); LAS float* RST = (LAS float*)(lds + 81984);
    for (int p = tid; p < 67 * 64; p += 512) { const int r = p >> 6, c16 = p & 63, tok = r - 3; v4u v = (v4u){0u, 0u, 0u, 0u};
        if (n * 64 + tok >= 0) v = *(const v4u*)(LX + (size_t)(t0 + tok) * 512 + c16 * 8);
        *(LAS v4u*)(XT + r * 520 + c16 * 8) = v; }
    for (int e = tid; e < 2560; e += 512) CW[e] = e < 2048 ? conv_w[e] : conv_b[e - 2048];
    __syncthreads();
    const int cb = wid, fr = lane & 15, fq = lane >> 4;
    const bf16x8* bfp = (const bf16x8*)(WAIF + (size_t)cb * 8192) + lane;
    float lsl[4], bav[4], biv[4], cw[4][4], cbv[4], h[4], Apr[4], og[4];
#pragma unroll
    for (int c = 0; c < 4; ++c) { const int d = 64 * cb + 16 * c + fr; const float lm = lam[d]; lsl[c] = -log1pf(__expf(-lm)); bav[c] = ba[d]; biv[c] = bi_[d];
#pragma unroll
        for (int tp = 0; tp < 4; ++tp) cw[tp][c] = CW[tp * 512 + d];
        cbv[c] = CW[2048 + d]; h[c] = 0.f; Apr[c] = 1.f; og[c] = PASS2 ? out_g[d] : 0.f; }
    if (PASS2) {
        for (int k = 0; k < n; ++k) {
#pragma unroll
            for (int c = 0; c < 4; ++c) { const int d = 64 * cb + 16 * c + fr; const f32x2 s = *(const f32x2*)(SUM + ((size_t)(b * 64 + k) * 512 + d) * 2); h[c] = s.x * h[c] + s.y; } }
    }
#pragma unroll 1
    for (int m = 0; m < 4; ++m) {
        float val[4][4];
        bf16x8 afrag[2];
#pragma unroll
        for (int kk = 0; kk < 2; ++kk) { const int c8 = 64 * cb + 32 * kk + 8 * fq; float a8[8];
            { const f32x4 b0 = *(const LAS f32x4*)(CW + 2048 + c8), b1 = *(const LAS f32x4*)(CW + 2048 + c8 + 4); a8[0] = b0.x; a8[1] = b0.y; a8[2] = b0.z; a8[3] = b0.w; a8[4] = b1.x; a8[5] = b1.y; a8[6] = b1.z; a8[7] = b1.w; }
#pragma unroll
            for (int tp = 0; tp < 4; ++tp) { const v4u xv = *(const LAS v4u*)(XT + (16 * m + fr + tp) * 520 + c8);
                const f32x4 w0 = *(const LAS f32x4*)(CW + tp * 512 + c8), w1 = *(const LAS f32x4*)(CW + tp * 512 + c8 + 4);
                a8[0] += w0.x * bf_lo(xv.x); a8[1] += w0.y * bf_hi(xv.x); a8[2] += w0.z * bf_lo(xv.y); a8[3] += w0.w * bf_hi(xv.y);
                a8[4] += w1.x * bf_lo(xv.z); a8[5] += w1.y * bf_hi(xv.z); a8[6] += w1.z * bf_lo(xv.w); a8[7] += w1.w * bf_hi(xv.w); }
            afrag[kk] = pack8(a8); }
        f32x4 acc[8];
#pragma unroll
        for (int nt = 0; nt < 8; ++nt) { const bf16x8 b0 = bfp[(nt * 2) * 64], b1 = bfp[(nt * 2 + 1) * 64]; acc[nt] = (f32x4){0.f, 0.f, 0.f, 0.f}; acc[nt] = MFMA16(afrag[0], b0, acc[nt]); acc[nt] = MFMA16(afrag[1], b1, acc[nt]); }
        __builtin_amdgcn_sched_barrier(0);
#pragma unroll
        for (int c = 0; c < 4; ++c) {
            const int dl = 64 * cb + 16 * c + fr;
            float av[4], uv[4];
#pragma unroll
            for (int rg = 0; rg < 4; ++rg) { const int tok = 16 * m + 4 * fq + rg;
                const float r_ = sigmoidf_(acc[c][rg] + bav[c]), i_ = sigmoidf_(acc[4 + c][rg] + biv[c]);
                const float la = 8.f * r_ * lsl[c]; const float a = __expf(la);
                float xc = cbv[c];
#pragma unroll
                for (int tp = 0; tp < 4; ++tp) xc += cw[tp][c] * bf2f(XT[(tok + tp) * 520 + dl]);
                av[rg] = a; uv[rg] = sqrtf(fmaxf(-expm1f(2.f * la), 0.f)) * (i_ * xc); }
            float Al = 1.f, Ul = 0.f;
#pragma unroll
            for (int rg = 0; rg < 4; ++rg) { Ul = av[rg] * Ul + uv[rg]; Al = av[rg] * Al; }
            float hin = h[c], hnext = h[c], Atot = 1.f;
#pragma unroll
            for (int q = 0; q < 4; ++q) { const float Aq = __shfl(Al, fr + 16 * q), Uq = __shfl(Ul, fr + 16 * q);
                hin = (q < fq) ? Aq * hin + Uq : hin; hnext = Aq * hnext + Uq; Atot *= Aq; }
            if (PASS2) { float hh = hin;
#pragma unroll
                for (int rg = 0; rg < 4; ++rg) { const int tok = 16 * m + 4 * fq + rg; hh = av[rg] * hh + uv[rg];
                    val[c][rg] = hh * geluf_(bf2f(LG[(size_t)(t0 + tok) * 512 + dl])); } }
            h[c] = hnext; Apr[c] *= Atot;
            __builtin_amdgcn_sched_barrier(0);
        }
        if (PASS2) {
#pragma unroll
            for (int rg = 0; rg < 4; ++rg) { float s = 0.f;
#pragma unroll
                for (int c = 0; c < 4; ++c) s += val[c][rg] * val[c][rg];
                s += __shfl_xor(s, 1); s += __shfl_xor(s, 2); s += __shfl_xor(s, 4); s += __shfl_xor(s, 8);
                if (fr == 0) PART[wid * 16 + 4 * fq + rg] = s; }
            __syncthreads();
            if (tid < 16) { float tot = 0.f;
#pragma unroll
                for (int w = 0; w < 8; ++w) tot += PART[w * 16 + tid];
                RST[tid] = rsqrtf(tot * (1.f / 512.f) + EPS); }
            __syncthreads();
#pragma unroll
            for (int rg = 0; rg < 4; ++rg) { const int tok = 16 * m + 4 * fq + rg; const float rs = RST[4 * fq + rg];
#pragma unroll
                for (int c = 0; c < 4; ++c) { const int d = 64 * cb + 16 * c + fr; Y[(size_t)(t0 + tok) * DM + d] = f2bf(val[c][rg] * rs * og[c]); } }
        }
    }
    if (!PASS2) {
        if (fq == 0) {
#pragma unroll
            for (int c = 0; c < 4; ++c) { const int d = 64 * cb + 16 * c + fr; *(f32x2*)(SUM + ((size_t)(b * 64 + n) * 512 + d) * 2) = (f32x2){Apr[c], h[c]}; } }
    }
    __syncthreads();
}

#ifndef GPSKIP
#define GPSKIP 0
#endif
DI int afrag_off4(int m, int k0, int nct) {
    return ((((m >> 5) * nct + (k0 >> 5)) * 2 + ((k0 >> 4) & 1)) * 64 + (m & 31) + 32 * ((k0 >> 2) & 1)) * 8 + 4 * ((k0 >> 3) & 1);
}
DI void gdn_pre_item(int it, const bf16* Qg, const bf16* Kg, const bf16* Vg, const float* BA, const float* convw, const float* a_log, const float* dt_bias,
                     unsigned char* GOP, float* GL, LAS unsigned char* lds, int tid, int lane, int wid) {
    asm volatile("" : "+v"(lane), "+v"(tid));
    const int n = it & 63, h = (it >> 6) & 3, b = it >> 8, t0 = b * SEQ + 64 * n;
    LAS bf16* KN = (LAS bf16*)(lds); LAS bf16* KB = (LAS bf16*)(lds + 17408); LAS bf16* QS = (LAS bf16*)(lds + 34816);
    LAS bf16* VBT = (LAS bf16*)(lds + 52224); LAS bf16* KBGT = (LAS bf16*)(lds + 70656);
    LAS float* LM = (LAS float*)(lds + 89088); LAS bf16* TB = (LAS bf16*)(lds + 106496);
    LAS float* GC = (LAS float*)(lds + 115712); LAS float* EG = (LAS float*)(lds + 116224); LAS float* EGL = (LAS float*)(lds + 116480);
    LAS bf16* LB21 = (LAS bf16*)(lds + 116736); LAS bf16* TBT = (LAS bf16*)(lds + 119296); LAS bf16* PT = (LAS bf16*)(lds + 121856);
    unsigned char* item = GOP + (size_t)it * GOP_ITEM;
    const int fr = lane & 15, fq = lane >> 4;
    float beta, gc, eg, egl;
    { const float braw = BA[(size_t)(t0 + lane) * 8 + h], araw = BA[(size_t)(t0 + lane) * 8 + 4 + h];
      beta = sigmoidf_(braw);
      const float xs = araw + dt_bias[h]; const float sp = xs > 20.f ? xs : log1pf(__expf(xs));
      float g = -__expf(a_log[h]) * sp;
#pragma unroll
      for (int o = 1; o < 64; o <<= 1) { const float v = __shfl_up(g, o); if (lane >= o) g += v; }
      gc = g; const float gl = __shfl(gc, 63); eg = __expf(gc); egl = __expf(gl - gc);
      if (wid == 0) { GC[lane] = gc; EG[lane] = eg; EGL[lane] = egl; if (lane == 0) GL[it] = gl; } }
    { const int c0 = h * 128 + 2 * lane;
      float wq[4][2], wk[4][2], wv[4][2];
#pragma unroll
      for (int tp = 0; tp < 4; ++tp)
#pragma unroll
          for (int e = 0; e < 2; ++e) { wq[tp][e] = convw[tp * 1536 + c0 + e]; wk[tp][e] = convw[tp * 1536 + 512 + c0 + e]; wv[tp][e] = convw[tp * 1536 + 1024 + c0 + e]; }
      unsigned xq[11], xk[11], xv[11];
#pragma unroll
      for (int r = 0; r < 11; ++r) { const int tok = 8 * wid - 3 + r; const bool ok = (n * 64 + tok) >= 0; const size_t off = (size_t)(t0 + tok) * 512 + c0;
          xq[r] = ok ? *(const unsigned*)(Qg + off) : 0u; xk[r] = ok ? *(const unsigned*)(Kg + off) : 0u; xv[r] = ok ? *(const unsigned*)(Vg + off) : 0u; }
#pragma unroll
      for (int i = 0; i < 8; ++i) { const int tt = 8 * wid + i;
          float q0 = 0.f, q1 = 0.f, k0 = 0.f, k1 = 0.f, v0 = 0.f, v1 = 0.f;
#pragma unroll
          for (int tp = 0; tp < 4; ++tp) { q0 += wq[tp][0] * bf_lo(xq[i + tp]); q1 += wq[tp][1] * bf_hi(xq[i + tp]); k0 += wk[tp][0] * bf_lo(xk[i + tp]); k1 += wk[tp][1] * bf_hi(xk[i + tp]);
              v0 += wv[tp][0] * bf_lo(xv[i + tp]); v1 += wv[tp][1] * bf_hi(xv[i + tp]); }
          q0 = siluf_(q0); q1 = siluf_(q1); k0 = siluf_(k0); k1 = siluf_(k1); v0 = siluf_(v0); v1 = siluf_(v1);
          const float rq = rsqrtf(wave_sum(q0 * q0 + q1 * q1) + EPS) * 0.08838834764831845f, rk = rsqrtf(wave_sum(k0 * k0 + k1 * k1) + EPS);
          const float bt = __shfl(beta, tt), egt = __shfl(eg, tt);
          q0 *= rq; q1 *= rq; k0 *= rk; k1 *= rk;
          *(LAS unsigned*)(KN + tt * 136 + 2 * lane) = pk2(k0, k1);
          *(LAS unsigned*)(KB + tt * 136 + 2 * lane) = pk2(k0 * bt, k1 * bt);
          *(LAS unsigned*)(QS + tt * 136 + 2 * lane) = pk2(q0, q1);
          VBT[(2 * lane) * 72 + tt] = f2bf(v0 * bt); VBT[(2 * lane + 1) * 72 + tt] = f2bf(v1 * bt);
          KBGT[(2 * lane) * 72 + tt] = f2bf(k0 * bt * egt); KBGT[(2 * lane + 1) * 72 + tt] = f2bf(k1 * bt * egt); } }
    __syncthreads();
    { const int sel = wid >> 2, mt = wid & 3;
      bf16x8 a[4];
      const LAS bf16* Asrc = sel == 0 ? KB : KN; const LAS bf16* Bsrc = sel == 0 ? KN : QS;
#pragma unroll
      for (int kk = 0; kk < 4; ++kk) a[kk] = *(const LAS bf16x8*)(Asrc + (16 * mt + fr) * 136 + 32 * kk + 8 * fq);
#pragma unroll
      for (int nt = 0; nt < 4; ++nt) { f32x4 acc = (f32x4){0.f, 0.f, 0.f, 0.f};
#pragma unroll
          for (int kk = 0; kk < 4; ++kk) { const bf16x8 bb = *(const LAS bf16x8*)(Bsrc + (16 * nt + fr) * 136 + 32 * kk + 8 * fq); acc = MFMA16(a[kk], bb, acc); }
          if (sel == 0) {
              const int j = 16 * nt + fr; const float gj = GC[j];
#pragma unroll
              for (int rg = 0; rg < 4; ++rg) { const int i = 16 * mt + 4 * fq + rg; const float lv = (j < i) ? acc[rg] * __expf(GC[i] - gj) : 0.f; LM[i * 68 + j] = lv;
                  if (i >= 32 && j < 32) LB21[(i - 32) * 40 + j] = f2bf(lv); }
          } else {
              const int i = 16 * nt + fr, j0 = 16 * mt + 4 * fq; const float gi = GC[i]; float v[4];
#pragma unroll
              for (int rg = 0; rg < 4; ++rg) { const int j = j0 + rg; v[rg] = (j <= i) ? acc[rg] * __expf(gi - GC[j]) : 0.f; }
              *(v2u*)((bf16*)(item + 49152) + afrag_off4(i, j0, 2)) = (v2u){pk2(v[0], v[1]), pk2(v[2], v[3])};
          } } }
    __syncthreads();
    if (wid == 0) {
        const int hh = lane >> 5, jj = lane & 31;
        float t[32];
#pragma unroll
        for (int i = 0; i < 32; ++i) t[i] = 0.f;
#pragma unroll
        for (int i = 0; i < 32; ++i) { float a0 = 0.f, a1 = 0.f, a2 = 0.f, a3 = 0.f;
#pragma unroll
            for (int k4 = 0; k4 < (i + 3) / 4; ++k4) { const f32x4 l = *(const LAS f32x4*)(LM + (i + 32 * hh) * 68 + 32 * hh + 4 * k4);
                a0 += l.x * t[4 * k4]; a1 += l.y * t[4 * k4 + 1]; a2 += l.z * t[4 * k4 + 2]; a3 += l.w * t[4 * k4 + 3]; }
            t[i] = ((jj == i) ? 1.f : 0.f) - ((a0 + a1) + (a2 + a3)); asm volatile("" ::: "memory"); }
#pragma unroll
        for (int i = 0; i < 32; ++i) TB[(32 * hh + i) * 72 + 32 * hh + jj] = f2bf(t[i]);
        if (hh == 0) {
#pragma unroll
            for (int i = 0; i < 32; ++i) TB[i * 72 + 32 + jj] = (bf16)0;
#pragma unroll
            for (int q = 0; q < 4; ++q) *(LAS bf16x8*)(TBT + jj * 40 + 8 * q) = pack8(t + 8 * q);
        }
        LDS_WAIT(); asm volatile("" ::: "memory");
#pragma unroll
        for (int mt = 0; mt < 2; ++mt)
#pragma unroll
            for (int nt = 0; nt < 2; ++nt) { const bf16x8 aa = *(const LAS bf16x8*)(LB21 + (16 * mt + fr) * 40 + 8 * fq), bb = *(const LAS bf16x8*)(TBT + (16 * nt + fr) * 40 + 8 * fq);
                const f32x4 acc = MFMA16(aa, bb, ((f32x4){0.f, 0.f, 0.f, 0.f}));
                *(LAS v2u*)(PT + (16 * nt + fr) * 40 + 16 * mt + 4 * fq) = (v2u){pk2(acc[0], acc[1]), pk2(acc[2], acc[3])}; }
        LDS_WAIT(); asm volatile("" ::: "memory");
#pragma unroll
        for (int mt = 0; mt < 2; ++mt)
#pragma unroll
            for (int nt = 0; nt < 2; ++nt) { const bf16x8 aa = *(const LAS bf16x8*)(TB + (32 + 16 * mt + fr) * 72 + 32 + 8 * fq), bb = *(const LAS bf16x8*)(PT + (16 * nt + fr) * 40 + 8 * fq);
                const f32x4 acc = MFMA16(aa, bb, ((f32x4){0.f, 0.f, 0.f, 0.f}));
#pragma unroll
                for (int rg = 0; rg < 4; ++rg) TB[(32 + 16 * mt + 4 * fq + rg) * 72 + 16 * nt + fr] = f2bf(-acc[rg]); }
    } else {
        for (int p = tid - 64; p < 2048; p += 448) { const int ln = p & 63, r = ln & 31, hh = ln >> 5; float o8[8];
            if (p < 1024) { const int f = p >> 6, mtile = f >> 3, ct = (f >> 1) & 3, s = f & 1; const int m = 32 * mtile + r, k0 = 32 * ct + 16 * s + 4 * hh; const float sc = EG[m];
                const v2u x0 = *(const LAS v2u*)(QS + m * 136 + k0), x1 = *(const LAS v2u*)(QS + m * 136 + k0 + 8);
                o8[0] = bf_lo(x0.x) * sc; o8[1] = bf_hi(x0.x) * sc; o8[2] = bf_lo(x0.y) * sc; o8[3] = bf_hi(x0.y) * sc; o8[4] = bf_lo(x1.x) * sc; o8[5] = bf_hi(x1.x) * sc; o8[6] = bf_lo(x1.y) * sc; o8[7] = bf_hi(x1.y) * sc;
                *(bf16x8*)((bf16*)(item + 16384) + (size_t)(f * 64 + ln) * 8) = pack8(o8);
            } else { const int f = (p - 1024) >> 6, mtile = f >> 2, ct = (f >> 1) & 1, s = f & 1; const int m = 32 * mtile + r, k0 = 32 * ct + 16 * s + 4 * hh;
#pragma unroll
                for (int j = 0; j < 4; ++j) { o8[j] = bf2f(KN[(k0 + j) * 136 + m]) * EGL[k0 + j]; o8[4 + j] = bf2f(KN[(k0 + 8 + j) * 136 + m]) * EGL[k0 + 8 + j]; }
                *(bf16x8*)((bf16*)(item + 32768) + (size_t)(f * 64 + ln) * 8) = pack8(o8); } }
    }
    __syncthreads();
    if (wid < 4) { const int mt = wid; bf16x8 a[2];
#pragma unroll
        for (int kk = 0; kk < 2; ++kk) a[kk] = *(const LAS bf16x8*)(TB + (16 * mt + fr) * 72 + 32 * kk + 8 * fq);
#pragma unroll
        for (int nt = 0; nt < 8; ++nt) { f32x4 acc = (f32x4){0.f, 0.f, 0.f, 0.f};
#pragma unroll
            for (int kk = 0; kk < 2; ++kk) { const bf16x8 bb = *(const LAS bf16x8*)(VBT + (16 * nt + fr) * 72 + 32 * kk + 8 * fq); acc = MFMA16(a[kk], bb, acc); }
            const int dv = 16 * nt + fr, tok0 = 16 * mt + 4 * fq, tt = tok0 & 31;
            const int off = (((dv >> 5) * 2 + (tok0 >> 5)) * 64 + (dv & 31) + 32 * ((tt >> 2) & 1)) * 16 + 4 * (tt >> 3);
            *(v2u*)((bf16*)(item + 57344) + off) = (v2u){pk2(acc[0], acc[1]), pk2(acc[2], acc[3])}; }
    } else {
#pragma unroll
        for (int mi = 0; mi < 2; ++mi) { const int mtp = 2 * (wid & 3) + mi; bf16x8 a[2];
#pragma unroll
            for (int kk = 0; kk < 2; ++kk) a[kk] = *(const LAS bf16x8*)(KBGT + (16 * mtp + fr) * 72 + 32 * kk + 8 * fq);
#pragma unroll
            for (int nt = 0; nt < 4; ++nt) { f32x4 acc = (f32x4){0.f, 0.f, 0.f, 0.f};
#pragma unroll
                for (int kk = 0; kk < 2; ++kk) { const bf16x8 bb = *(const LAS bf16x8*)(TB + (16 * nt + fr) * 72 + 32 * kk + 8 * fq); acc = MFMA16(a[kk], bb, acc); }
                const int tok = 16 * nt + fr, dk0 = 16 * mtp + 4 * fq;
                *(v2u*)((bf16*)(item) + afrag_off4(tok, dk0, 4)) = (v2u){pk2(acc[0], acc[1]), pk2(acc[2], acc[3])}; } }
    }
    __syncthreads();
}

DI void gdn_scan(int bt, const unsigned char* GOP, const float* GL, float* O, LAS unsigned char* lds, int tid, int lane, int wid) {
    const int bh = (bt & 7) + 8 * (bt >> 4), dvh = (bt >> 3) & 1, b = bh >> 2, h = bh & 3;
    const unsigned char* base = GOP + (size_t)(bh * 64) * GOP_ITEM;
    const bool comp = wid < 2;
    const int lt = tid - 128;
    f32x16 S[4];
#pragma unroll
    for (int c = 0; c < 4; ++c)
#pragma unroll
        for (int r = 0; r < 16; ++r) S[c][r] = 0.f;
    v4u stage[11];
#define SCAN_LOAD(nn) do { const unsigned char* ib = base + (size_t)(nn) * GOP_ITEM; \
        _Pragma("unroll") for (int q = 0; q < 11; ++q) { const int p = lt + 384 * q; if (p < 4096) stage[q] = *(const v4u*)(p < 3584 ? ib + p * 16 : ib + 57344 + dvh * 8192 + (p - 3584) * 16); } } while (0)
#define SCAN_STORE(slotp) do { _Pragma("unroll") for (int q = 0; q < 11; ++q) { const int p = lt + 384 * q; if (p < 4096) *(LAS v4u*)((slotp) + p * 16) = stage[q]; } } while (0)
    const int r = lane & 31, hh = lane >> 5, dvt = 2 * dvh + wid;
    if (!comp) {
        SCAN_LOAD(0); SCAN_STORE(lds);
        __syncthreads();
        for (int n = 0; n < 64; ++n) {
            LAS unsigned char* nsl = lds + ((n + 1) & 1) * 65536;
            if (n + 1 < 64) { SCAN_LOAD(n + 1); SCAN_STORE(nsl); }
            __syncthreads();
        }
    } else {
        __syncthreads();
        for (int n = 0; n < 64; ++n) {
            LAS unsigned char* sl = lds + (n & 1) * 65536;
#define FRAG(region, f) (*(const LAS bf16x8*)(sl + (region) + ((f) * 64 + lane) * 16))
            const float egl = __expf(ld_f32(GL + bh * 64 + n));
            bf16x8 Sb[4][2];
#pragma unroll
            for (int c = 0; c < 4; ++c) { Sb[c][0] = pack_step<0>(S[c]); Sb[c][1] = pack_step<1>(S[c]); }
            bf16x8 Vb[2][2];
#pragma unroll
            for (int mt = 0; mt < 2; ++mt) { f32x16 X;
#pragma unroll
                for (int q = 0; q < 16; ++q) X[q] = 0.f;
#pragma unroll
                for (int c = 0; c < 4; ++c)
#pragma unroll
                    for (int s = 0; s < 2; ++s) X = MFMA32(FRAG(0, (mt * 4 + c) * 2 + s), Sb[c][s], X);
                const LAS unsigned char* up = sl + 57344 + wid * 4096 + (mt * 64 + lane) * 32;
                const v4u u0 = *(const LAS v4u*)up, u1 = *(const LAS v4u*)(up + 16);
                f32x16 vn;
                vn[0] = bf_lo(u0.x) - X[0]; vn[1] = bf_hi(u0.x) - X[1]; vn[2] = bf_lo(u0.y) - X[2]; vn[3] = bf_hi(u0.y) - X[3];
                vn[4] = bf_lo(u0.z) - X[4]; vn[5] = bf_hi(u0.z) - X[5]; vn[6] = bf_lo(u0.w) - X[6]; vn[7] = bf_hi(u0.w) - X[7];
                vn[8] = bf_lo(u1.x) - X[8]; vn[9] = bf_hi(u1.x) - X[9]; vn[10] = bf_lo(u1.y) - X[10]; vn[11] = bf_hi(u1.y) - X[11];
                vn[12] = bf_lo(u1.z) - X[12]; vn[13] = bf_hi(u1.z) - X[13]; vn[14] = bf_lo(u1.w) - X[14]; vn[15] = bf_hi(u1.w) - X[15];
                Vb[mt][0] = pack_step<0>(vn); Vb[mt][1] = pack_step<1>(vn); }
#pragma unroll
            for (int mt = 0; mt < 2; ++mt) { f32x16 Oa;
#pragma unroll
                for (int q = 0; q < 16; ++q) Oa[q] = 0.f;
#pragma unroll
                for (int c = 0; c < 4; ++c)
#pragma unroll
                    for (int s = 0; s < 2; ++s) Oa = MFMA32(FRAG(16384, (mt * 4 + c) * 2 + s), Sb[c][s], Oa);
#pragma unroll
                for (int c2 = 0; c2 < 2; ++c2)
#pragma unroll
                    for (int s = 0; s < 2; ++s) Oa = MFMA32(FRAG(49152, (mt * 2 + c2) * 2 + s), Vb[c2][s], Oa);
                float* orow = O + (size_t)(b * SEQ + 64 * n + 32 * mt + 4 * hh) * 512 + h * 128 + dvt * 32 + r;
#pragma unroll
                for (int q = 0; q < 16; ++q) orow[(size_t)((q & 3) + 8 * (q >> 2)) * 512] = Oa[q]; }
#pragma unroll
            for (int c4 = 0; c4 < 4; ++c4) { S[c4] = S[c4] * egl;
#pragma unroll
                for (int c2 = 0; c2 < 2; ++c2)
#pragma unroll
                    for (int s = 0; s < 2; ++s) S[c4] = MFMA32(FRAG(32768, (c4 * 2 + c2) * 2 + s), Vb[c2][s], S[c4]); }
#undef FRAG
            __syncthreads();
        }
    }
#undef SCAN_LOAD
#undef SCAN_STORE
}

DI void gdn_post(const float* O, const bf16* Z, const float* out_g, bf16* Y, int lane, int gw, int NGW) {
    const int c0 = 8 * lane;
    float og[8];
#pragma unroll
    for (int e = 0; e < 8; ++e) og[e] = out_g[(c0 & 127) + e];
    for (int t = gw; t < T; t += NGW) {
        const f32x4 a = *(const f32x4*)(O + (size_t)t * 512 + c0), b = *(const f32x4*)(O + (size_t)t * 512 + c0 + 4);
        const v4u z = *(const v4u*)(Z + (size_t)t * 512 + c0);
        float ss = (a.x * a.x + a.y * a.y) + (a.z * a.z + a.w * a.w) + (b.x * b.x + b.y * b.y) + (b.z * b.z + b.w * b.w);
        ss += __shfl_xor(ss, 1); ss += __shfl_xor(ss, 2); ss += __shfl_xor(ss, 4); ss += __shfl_xor(ss, 8);
        const float rs = rsqrtf(ss * (1.f / 128.f) + EPS);
        v4u o;
        o.x = pk2(a.x * rs * og[0] * siluf_(bf_lo(z.x)), a.y * rs * og[1] * siluf_(bf_hi(z.x)));
        o.y = pk2(a.z * rs * og[2] * siluf_(bf_lo(z.y)), a.w * rs * og[3] * siluf_(bf_hi(z.y)));
        o.z = pk2(b.x * rs * og[4] * siluf_(bf_lo(z.z)), b.y * rs * og[5] * siluf_(bf_hi(z.z)));
        o.w = pk2(b.z * rs * og[6] * siluf_(bf_lo(z.w)), b.w * rs * og[7] * siluf_(bf_hi(z.w)));
        *(v4u*)(Y + (size_t)t * DM + 512 + c0) = o;
    }
}

DI void router_rows(const float* H1, const float* WRT, const float* b_rg, const float* b_re, bf16* XN2, unsigned* cnt, unsigned* TOK, int lane, int gw, int NGW) {
    for (int t = gw; t < T; t += NGW) {
        const f32x4* hr = (const f32x4*)(H1 + (size_t)t * DM);
        f32x4 v[4]; float ss = 0.f;
#pragma unroll
        for (int j = 0; j < 4; ++j) { v[j] = hr[lane + 64 * j]; ss += (v[j].x * v[j].x + v[j].y * v[j].y) + (v[j].z * v[j].z + v[j].w * v[j].w); }
        const float rs = rsqrtf(wave_sum(ss) * (1.f / DM) + EPS);
#pragma unroll
        for (int j = 0; j < 4; ++j) *(v2u*)(XN2 + (size_t)t * DM + 4 * (lane + 64 * j)) = (v2u){pk2(v[j].x * rs, v[j].y * rs), pk2(v[j].z * rs, v[j].w * rs)};
        float gl4[4];
#pragma unroll
        for (int c = 0; c < 4; ++c) { const f32x4* wr = (const f32x4*)(WRT + c * 1024); float d = 0.f;
#pragma unroll
            for (int j = 0; j < 4; ++j) { const f32x4 w = wr[lane + 64 * j]; d += (v[j].x * w.x + v[j].y * w.y) + (v[j].z * w.z + v[j].w * w.w); }
            gl4[c] = wave_sum(d) * rs + b_rg[c]; }
        float gmax = gl4[0]; int gs = 0;
#pragma unroll
        for (int c = 1; c < 4; ++c) if (gl4[c] > gmax) { gmax = gl4[c]; gs = c; }
        float den = 0.f;
#pragma unroll
        for (int c = 0; c < 4; ++c) den += __expf(gl4[c] - gmax);
        const float pg = 1.f / den;
        gs = __builtin_amdgcn_readfirstlane(gs);
        float el[8];
#pragma unroll
        for (int i = 0; i < 8; ++i) { const f32x4* wr = (const f32x4*)(WRT + (4 + 8 * gs + i) * 1024); float d = 0.f;
#pragma unroll
            for (int j = 0; j < 4; ++j) { const f32x4 w = wr[lane + 64 * j]; d += (v[j].x * w.x + v[j].y * w.y) + (v[j].z * w.z + v[j].w * w.w); }
            el[i] = wave_sum(d) * rs + b_re[8 * gs + i]; }
        float m0 = el[0]; int i0 = 0;
#pragma unroll
        for (int i = 1; i < 8; ++i) if (el[i] > m0) { m0 = el[i]; i0 = i; }
        float m1 = -3.0e38f; int i1 = 0;
#pragma unroll
        for (int i = 0; i < 8; ++i) if (i != i0 && el[i] > m1) { m1 = el[i]; i1 = i; }
        const float q = __expf(m1 - m0);
        const float g0 = pg / (1.f + q), g1 = pg * q / (1.f + q);
        if (lane == 0) { const int e0 = 8 * gs + i0, e1 = 8 * gs + i1;
            const unsigned p0 = atomicAdd(cnt + e0, 1u), p1 = atomicAdd(cnt + e1, 1u);
            TOK[t] = (unsigned)e0; TOK[T + t] = (unsigned)e1; TOK[2 * T + t] = __float_as_uint(g0); TOK[3 * T + t] = __float_as_uint(g1); TOK[4 * T + t] = p0; TOK[5 * T + t] = p1; }
    }
}

DI void moe_scatter(const bf16* XN2, const unsigned* cnt, unsigned* TOK, bf16* XS, float* SLOTG, unsigned* TILE, int lane, int gw, int NGW, bool leader) {
    const int c = lane < 32 ? (int)ld_u32(cnt + lane) : 0; const int padded = (c + 255) & ~255;
    int pe = padded;
#pragma unroll
    for (int o = 1; o < 64; o <<= 1) { const int v = __shfl_up(pe, o); if (lane >= o) pe += v; }
    const int ps = pe - padded;
    if (leader) {
        int cle[5] = {0, 0, 0, 0, 0};
#pragma unroll
        for (int e = 0; e < 32; ++e) { const int pee = __shfl(pe, e);
#pragma unroll
            for (int q = 0; q < 5; ++q) cle[q] += (pee <= (lane + 64 * q) * 256) ? 1 : 0; }
#pragma unroll
        for (int q = 0; q < 5; ++q) { const int pm = lane + 64 * q; if (pm < 288) TILE[pm] = (unsigned)(cle[q] < 31 ? cle[q] : 31); }
        const int tot = __shfl(pe, 31);
        if (lane == 0) TILE[300] = (unsigned)(tot >> 8);
    }
    for (int t = gw; t < T; t += NGW) {
        const int e0 = (int)TOK[t], e1 = (int)TOK[T + t];
        const int d0 = __shfl(ps, e0) + (int)TOK[4 * T + t], d1 = __shfl(ps, e1) + (int)TOK[5 * T + t];
        const v4u a = ((const v4u*)(XN2 + (size_t)t * DM))[lane], b = ((const v4u*)(XN2 + (size_t)t * DM))[lane + 64];
        ((v4u*)(XS + (size_t)d0 * DM))[lane] = a; ((v4u*)(XS + (size_t)d0 * DM))[lane + 64] = b;
        ((v4u*)(XS + (size_t)d1 * DM))[lane] = a; ((v4u*)(XS + (size_t)d1 * DM))[lane + 64] = b;
        if (lane == 0) { SLOTG[d0] = __uint_as_float(TOK[2 * T + t]); SLOTG[d1] = __uint_as_float(TOK[3 * T + t]); TOK[6 * T + t] = (unsigned)d0; TOK[7 * T + t] = (unsigned)d1; }
    }
}

DI void moe_combine(float* H1, const bf16* YB, const unsigned* TOK, bf16* XN3, int lane, int gw, int NGW) {
    for (int t = gw; t < T; t += NGW) {
        const int d0 = (int)TOK[6 * T + t], d1 = (int)TOK[7 * T + t];
        f32x4* hr = (f32x4*)(H1 + (size_t)t * DM); const v2u* y0 = (const v2u*)(YB + (size_t)d0 * DM); const v2u* y1 = (const v2u*)(YB + (size_t)d1 * DM);
        f32x4 v[4]; float ss = 0.f;
#pragma unroll
        for (int j = 0; j < 4; ++j) { const f32x4 hv = hr[lane + 64 * j]; const v2u a = y0[lane + 64 * j], b = y1[lane + 64 * j];
            v[j].x = hv.x + bf_lo(a.x) + bf_lo(b.x); v[j].y = hv.y + bf_hi(a.x) + bf_hi(b.x); v[j].z = hv.z + bf_lo(a.y) + bf_lo(b.y); v[j].w = hv.w + bf_hi(a.y) + bf_hi(b.y);
            hr[lane + 64 * j] = v[j]; ss += (v[j].x * v[j].x + v[j].y * v[j].y) + (v[j].z * v[j].z + v[j].w * v[j].w); }
        const float rs = rsqrtf(wave_sum(ss) * (1.f / DM) + EPS);
#pragma unroll
        for (int j = 0; j < 4; ++j) *(v2u*)(XN3 + (size_t)t * DM + 4 * (lane + 64 * j)) = (v2u){pk2(v[j].x * rs, v[j].y * rs), pk2(v[j].z * rs, v[j].w * rs)};
    }
}

constexpr int NPHASE = 13;
#ifndef TESTSEL
#define TESTSEL 0
#endif
__global__ void __launch_bounds__(512, 2) hymba_fwd(Params P) {
    extern __shared__ __attribute__((aligned(16))) unsigned char lds_raw[];
    LAS unsigned char* lds = (LAS unsigned char*)lds_raw;
    cg::grid_group grid = cg::this_grid();
    const int tid = threadIdx.x, lane = tid & 63, wid = __builtin_amdgcn_readfirstlane(tid >> 6);
    const int G = gridDim.x, bid = blockIdx.x, gw = bid * 8 + wid, NGW = G * 8;
    unsigned char* ws = P.ws;
    bf16* PROJ = (bf16*)(ws + WS_PROJ);
    const bf16* LX = PROJ; const bf16* LG = PROJ + (size_t)T * 512; const bf16* Qg = PROJ + (size_t)2 * T * 512; const bf16* Kg = PROJ + (size_t)3 * T * 512;
    const bf16* Vg = PROJ + (size_t)4 * T * 512; const bf16* Zg = PROJ + (size_t)5 * T * 512;
    unsigned* CTL = (unsigned*)(ws + WS_CTL); unsigned* cnt = CTL; float* RS4 = (float*)(ws + WS_CTL + 4096);
    unsigned* TOK = (unsigned*)(ws + WS_TOK); unsigned* TILE = (unsigned*)(ws + WS_TILE);
    float* H1 = (float*)(ws + WS_H1);
#ifndef PHMASK
#define PHMASK 0xFFFF
#endif
#define IN(k) (((PHMASK >> (k)) & 1) && P.ph_lo <= (k) && (k) < P.ph_hi)
#define SYNC(k) do { if (IN(k) && IN((k) + 1)) grid.sync(); } while (0)

    if (IN(0)) phase0(P, lds, tid, lane, wid, gw, NGW);
    SYNC(0);
    if (IN(1)) {
        pg8::Gemm g{(const bf16*)(ws + WS_XN1), (const bf16*)(ws + WS_WINT), T, 3072, 1024}; pg8::StaticOrder S; S.init(T, 3072, G, bid);
        pg8::EpiBf16<0> E{PROJ, 512, nullptr, 512, (size_t)T * 512, 1.f};
        pg8::gemm_phase<pg8::EpiBf16<0>, pg8::StaticOrder, true, true>(lds, g, S, E);
    }
    SYNC(1);
    if (IN(2)) {
        if (!(TESTSEL & 1)) for (int bi = bid; bi < 512; bi += G)
            lru_item<false>(bi, LX, LG, P.in[4], P.in[5], (const bf16*)(ws + WS_WAIF), P.in[7], P.in[9], P.in[10], P.in[11], (float*)(ws + WS_SUM), (bf16*)(ws + WS_Y), lds, tid, lane, wid);
        if (!(TESTSEL & 2)) for (int it = bid; it < 2048; it += G)
            gdn_pre_item(it, Qg, Kg, Vg, (const float*)(ws + WS_BA), P.in[12], P.in[13], P.in[14], ws + WS_GOP, (float*)(ws + WS_GL), lds, tid, lane, wid);
    }
    SYNC(2);
    if (IN(3)) {
        if (bid < 64) { if (!(TESTSEL & 4)) gdn_scan(bid, ws + WS_GOP, (const float*)(ws + WS_GL), (float*)(ws + WS_O), lds, tid, lane, wid); }
        else if (!(TESTSEL & 8)) for (int bi = bid - 64; bi < 512; bi += G - 64)
            lru_item<true>(bi, LX, LG, P.in[4], P.in[5], (const bf16*)(ws + WS_WAIF), P.in[7], P.in[9], P.in[10], P.in[11], (float*)(ws + WS_SUM), (bf16*)(ws + WS_Y), lds, tid, lane, wid);
    }
    SYNC(3);
    if (IN(4)) gdn_post((const float*)(ws + WS_O), Zg, P.in[15], (bf16*)(ws + WS_Y), lane, gw, NGW);
    SYNC(4);
    if (IN(5)) {
        pg8::Gemm g{(const bf16*)(ws + WS_Y), (const bf16*)(ws + WS_WOUTT), T, 1024, 1024}; pg8::StaticOrder S; S.init(T, 1024, G, bid);
        EpiRes E{H1, P.in[0]};
        pg8::gemm_phase<EpiRes, pg8::StaticOrder, true, true>(lds, g, S, E);
    }
    SYNC(5);
    if (IN(6)) {
        router_rows(H1, (const float*)(ws + WS_WRT), P.in[19], P.in[21], (bf16*)(ws + WS_XN2), cnt, TOK, lane, gw, NGW);
        LAS float* scr = (LAS float*)(lds + wid * 8448);
        for (int it = gw; it < 24576; it += NGW) {
            int r = it;
            if (r < 16384) { const bool up = r >= 8192; r &= 8191; const int e = r >> 8, kb = (r >> 4) & 15, nb = r & 15, n0 = 32 * nb;
                transpose_item((up ? P.in[23] : P.in[22]) + (size_t)e * 1024 * 512, 512, P.in[17], (bf16*)(ws + WS_WGUT), 1024, e * 1024 + (n0 >> 7) * 256 + (up ? 128 : 0) + (n0 & 127), 64 * kb, n0, scr, lane);
            } else { r -= 16384; const int e = r >> 8, kb = (r >> 5) & 7, nb = r & 31;
                transpose_item(P.in[24] + (size_t)e * 512 * 1024, 1024, nullptr, (bf16*)(ws + WS_WDT), 512, e * 1024 + 32 * nb, 64 * kb, 32 * nb, scr, lane); }
        }
    }
    SYNC(6);
    if (IN(7)) moe_scatter((const bf16*)(ws + WS_XN2), cnt, TOK, (bf16*)(ws + WS_XS), (float*)(ws + WS_SLOTG), TILE, lane, gw, NGW, bid == 0 && wid == 0);
    SYNC(7);
    if (IN(8)) {
        const int ntile = (int)__builtin_amdgcn_readfirstlane(ld_u32(TILE + 300));
        pg8::Gemm g{(const bf16*)(ws + WS_XS), (const bf16*)(ws + WS_WGUT), 0, 0, 1024}; MoeSched S{TILE, ntile * 4, G, bid};
        EpiSwiglu E{(bf16*)(ws + WS_HB)};
        pg8::gemm_phase<EpiSwiglu, MoeSched, true, true>(lds, g, S, E);
    }
    SYNC(8);
    if (IN(9)) {
        const int ntile = (int)__builtin_amdgcn_readfirstlane(ld_u32(TILE + 300));
        pg8::Gemm g{(const bf16*)(ws + WS_HB), (const bf16*)(ws + WS_WDT), 0, 0, 512}; MoeSched S{TILE, ntile * 4, G, bid};
        EpiDown E{(bf16*)(ws + WS_YB), (const float*)(ws + WS_SLOTG)};
        pg8::gemm_phase<EpiDown, MoeSched, true, true>(lds, g, S, E);
    }
    SYNC(9);
    if (IN(10)) {
        moe_combine(H1, (const bf16*)(ws + WS_YB), TOK, (bf16*)(ws + WS_XN3), lane, gw, NGW);
        __syncthreads();
        pg8::Gemm g{(const bf16*)(ws + WS_PB), (const bf16*)(ws + WS_WPT), T, 1024, 256}; pg8::StaticOrder S; S.init(T, 1024, G, bid);
        pg8::EpiBf16<0> E{(bf16*)(ws + WS_PE), 1024, nullptr, 0, 0, 1.f};
        pg8::gemm_phase<pg8::EpiBf16<0>, pg8::StaticOrder, true, true>(lds, g, S, E);
    }
    SYNC(10);
    if (IN(11)) {
        pg8::Gemm g{(const bf16*)(ws + WS_XN3), (const bf16*)(ws + WS_WPGT), T, 1024, 1024}; pg8::StaticOrder S; S.init(T, 1024, G, bid);
        EpiPle E{H1, (const bf16*)(ws + WS_PE), RS4};
        pg8::gemm_phase<EpiPle, pg8::StaticOrder, true, true>(lds, g, S, E);
    }
    SYNC(11);
    if (IN(12)) {
        const f32x4* h4 = (const f32x4*)H1; const f32x4* nf4 = (const f32x4*)P.in[28]; f32x4* o4 = (f32x4*)P.out;
        for (int i = bid * 512 + tid; i < T * 256; i += G * 512) { const int t = i >> 8; const float rs = rsqrtf(ld_f32(RS4 + t) * (1.f / DM) + EPS); o4[i] = h4[i] * rs * nf4[i & 255]; }
    }
#undef IN
#undef SYNC
}

extern "C" void kernel_launch(void* const* d_in, const int* in_sizes, int n_in, void* d_out, int out_size, void* d_ws, size_t ws_size, hipStream_t stream) {
    static int grid = 0;
    if (grid == 0) {
        if (n_in != 29 || out_size != T * DM || ws_size < WS_END) { fprintf(stderr, "kernel_launch: unexpected shapes (n_in %d out %d ws %zu)\n", n_in, out_size, ws_size); grid = -1; return; }
        int dev = 0, cus = 0, per_cu = 0;
        hipGetDevice(&dev); hipDeviceGetAttribute(&cus, hipDeviceAttributeMultiprocessorCount, dev);
        hipFuncSetAttribute((const void*)hymba_fwd, hipFuncAttributeMaxDynamicSharedMemorySize, LDS_BYTES);
        hipOccupancyMaxActiveBlocksPerMultiprocessor(&per_cu, (const void*)hymba_fwd, 512, LDS_BYTES);
        (void)hipGetLastError();
        if (per_cu < 1) { fprintf(stderr, "kernel_launch: occupancy query says %d blocks per CU\n", per_cu); per_cu = 1; }
        grid = cus;
    }
    if (grid < 0) return;
    hipMemsetAsync((char*)d_ws + WS_CTL, 0, 1 * MiB, stream);
    Params p{};
    for (int i = 0; i < 29; ++i) p.in[i] = (const float*)d_in[i];
    p.out = (float*)d_out; p.ws = (unsigned char*)d_ws; p.ph_lo = 0; p.ph_hi = NPHASE;
    void* args[] = {&p};
    hipError_t e = hipLaunchCooperativeKernel((const void*)hymba_fwd, dim3(grid), dim3(512), args, LDS_BYTES, stream);
    if (e != hipSuccess) fprintf(stderr, "cooperative launch failed: %s (grid %d)\n", hipGetErrorString(e), grid);
}
```

```cpp
#include <hip/hip_runtime.h>
#include <hip/hip_cooperative_groups.h>
#include <cstdio>
#include <cstdint>
namespace cg = cooperative_groups;
namespace pg8 {
#define PG8_LAS __attribute__((address_space(3)))
typedef unsigned short bf16_t;
typedef short bf16x8 __attribute__((ext_vector_type(8)));
typedef float f32x4 __attribute__((ext_vector_type(4)));
typedef unsigned u32x4 __attribute__((ext_vector_type(4)));
constexpr int BM = 256, BK = 64, HALF = 128, HTB = HALF * BK * 2  , STAGE_BYTES = 8 * HTB, NXCD = 8, WGM = 8;

__host__ __device__ __forceinline__ int lds_byte(int r, int c) { const int st = (r >> 4) * 2 + (c >> 5), rr = r & 15, cc = c & 31, ob = rr * 64 + cc * 2; return st * 1024 + (ob ^ (((ob >> 9) & 1) << 5)); }
__host__ __device__ __forceinline__ void stage_rc(int b, int& R, int& C) { const int st = b / 1024, sb = b % 1024, swz = sb ^ (((sb >> 9) & 1) << 5); R = (st >> 1) * 16 + swz / 64; C = (st & 1) * 32 + (swz % 64) / 2; }
__host__ __device__ __forceinline__ int perm32(int rho) { const int n = rho >> 4, i = rho & 15; return 8 * (i >> 2) + 4 * n + (i & 3); }

struct Unit { int pm, pn; };
struct Gemm { const bf16_t* A; const bf16_t* Bt; int M, N, K; };

struct StaticOrder {
    int nM, nN, nwg, G, c;
    __host__ __device__ void init(int M, int N, int G_, int c_) { nM = M / BM; nN = N / BM; nwg = nM * nN; G = G_; c = c_; }
    __host__ __device__ bool next(int i, Unit& u) const {
        const long L = (long)i * G + c; if (L >= nwg) return false;
        int wgid = (int)L; { const int q = nwg / NXCD, r = nwg % NXCD, xcd = wgid % NXCD, off = wgid / NXCD; wgid = (xcd < r ? xcd * (q + 1) : r * (q + 1) + (xcd - r) * q) + off; }
        const int nig = WGM * nN, gid = wgid / nig, fm = gid * WGM, gsz = (nM - fm) < WGM ? (nM - fm) : WGM;
        u.pm = fm + ((wgid % nig) % gsz); u.pn = (wgid % nig) / gsz; return true;
    }
    __device__ __forceinline__ void a_ready(const Unit&) const {}
    __device__ __forceinline__ void done(const Unit&) const {}
};

__device__ __forceinline__ unsigned cvt_pk_bf16(float lo, float hi) { unsigned r; asm volatile("v_cvt_pk_bf16_f32 %0, %1, %2" : "=v"(r) : "v"(lo), "v"(hi)); return r; }
typedef float f32x2 __attribute__((ext_vector_type(2)));
__device__ __forceinline__ f32x2 gelu_pk(f32x2 v) {
    const f32x2 av = __builtin_elementwise_abs(v), d = av * 0.2316418882f + 1.0f;
    f32x2 t; t.x = __builtin_amdgcn_rcpf(d.x); t.y = __builtin_amdgcn_rcpf(d.y);
    f32x2 q = t * 0.5307027145f + (-0.7265760135f); q = q * t + 0.7107068705f; q = q * t + (-0.142248368f); q = q * t + 0.127414796f; q = q * t;
    const f32x2 s = (v * v) * (-0.72134752044f);
    f32x2 e; e.x = __builtin_amdgcn_exp2f(s.x); e.y = __builtin_amdgcn_exp2f(s.y);
    const f32x2 m = v * (q * e), r = v - m;
    f32x2 o; o.x = v.x < 0.f ? m.x : r.x; o.y = v.y < 0.f ? m.y : r.y; return o;
}

template <int ACT  > struct EpiBf16 {
    static constexpr bool PERM = true, AFTER_DRAIN = false; static_assert(ACT == 0 || ACT == 1, "EpiBf16: ACT is 0 (none) or 1 (gelu_pk)");
    bf16_t* O; int ldc; const float* bias; int split_cols; size_t split_stride; float scale0;
    __device__ __forceinline__ void operator()(const f32x4 (&acc)[2][2][4][2], const Unit& u, int wr, int wc, int fr, int fq) const {
        const int row0 = u.pm * BM + wr * 64 + fr; int colt = u.pn * BM; bf16_t* base = O;
        float sc = 1.f; if (split_cols) { const int t = colt / split_cols; base += (size_t)t * split_stride; colt -= t * split_cols; if (t == 0) sc = scale0; }
        const int col0 = colt + wc * 32 + 8 * fq, bcol0 = u.pn * BM + wc * 32 + 8 * fq;
        f32x4 bv[2][2];
#pragma unroll
        for (int bj = 0; bj < 2; ++bj)
#pragma unroll
            for (int n = 0; n < 2; ++n) bv[bj][n] = bias ? *(const f32x4*)(bias + bcol0 + bj * HALF + 4 * n) : (f32x4){0.f, 0.f, 0.f, 0.f};
#pragma unroll
        for (int ai = 0; ai < 2; ++ai)
#pragma unroll
            for (int m = 0; m < 4; ++m) { bf16_t* rowp = base + (size_t)(row0 + ai * HALF + m * 16) * ldc + col0;
#pragma unroll
                for (int bj = 0; bj < 2; ++bj) { f32x4 v0 = acc[ai][bj][m][0] + bv[bj][0], v1 = acc[ai][bj][m][1] + bv[bj][1];
                    if (ACT == 1) { f32x2 a = gelu_pk((f32x2){v0[0], v0[1]}), b = gelu_pk((f32x2){v0[2], v0[3]}), c = gelu_pk((f32x2){v1[0], v1[1]}), d = gelu_pk((f32x2){v1[2], v1[3]});
                        v0 = (f32x4){a.x, a.y, b.x, b.y}; v1 = (f32x4){c.x, c.y, d.x, d.y}; }
                    v0 = v0 * sc; v1 = v1 * sc; u32x4 w; w.x = cvt_pk_bf16(v0[0], v0[1]); w.y = cvt_pk_bf16(v0[2], v0[3]); w.z = cvt_pk_bf16(v1[0], v1[1]); w.w = cvt_pk_bf16(v1[2], v1[3]);
                    *(u32x4*)(rowp + bj * HALF) = w; } }
    }
};
template <class Epi, class Sched, bool ALIGN_EPI = false, bool SP2 = false>
__device__ __forceinline__ void gemm_phase(PG8_LAS unsigned char* lds, const Gemm g, const Sched& S, const Epi& E) {
    const int tid = threadIdx.x, wid = __builtin_amdgcn_readfirstlane(tid >> 6), lane = tid & 63, wr = wid >> 2, wc = wid & 3, fr = lane & 15, fq = lane >> 4;
    const int K = g.K, nt = K / BK;
    unsigned voffA[2], voffB[2];
#pragma unroll
    for (int i = 0; i < 2; ++i) { int R, C; stage_rc(tid * 16 + i * 8192, R, C); const int Rb = Epi::PERM ? ((R & ~31) + perm32(R & 31)) : R;
        voffA[i] = (unsigned)(R * K + C) * 2u; voffB[i] = (unsigned)(Rb * K + C) * 2u; }
    const size_t kstep = (size_t)(BK * 2);
    const size_t hstep = (size_t)HALF * K * 2;
    const size_t tstep = 2 * hstep;
    const unsigned ldsw = (unsigned)wid * 1024u;
    const int aoff = lds_byte(wr * 64 + fr, fq * 8), boff = lds_byte(wc * 32 + fr, fq * 8);
#define PG8_SA(b, h) (((b) * 2 + (h)) * HTB)
#define PG8_SB(b, h) ((4 + (b) * 2 + (h)) * HTB)
#define PG8_STAGE(bufoff, gbase, voff) do { _Pragma("unroll") for (int _i = 0; _i < 2; ++_i) \
        __builtin_amdgcn_global_load_lds((const unsigned*)((const char*)(gbase) + (voff)[_i]), (PG8_LAS unsigned*)(lds + (bufoff) + ldsw + _i * 8192), 16, 0, 0); } while (0)
#define PG8_LDA(dst, b, h) do { _Pragma("unroll") for (int m = 0; m < 4; ++m) _Pragma("unroll") for (int k = 0; k < 2; ++k) dst[m][k] = *(const PG8_LAS bf16x8*)(lds + PG8_SA(b, h) + aoff + m * 2048 + k * 1024); } while (0)
#define PG8_LDB(dst, b, h) do { _Pragma("unroll") for (int n = 0; n < 2; ++n) _Pragma("unroll") for (int k = 0; k < 2; ++k) dst[n][k] = *(const PG8_LAS bf16x8*)(lds + PG8_SB(b, h) + boff + n * 2048 + k * 1024); } while (0)
#define PG8_MMA(ai, bj, At, Bt) do { __builtin_amdgcn_s_setprio(1); _Pragma("unroll") for (int m = 0; m < 4; ++m) _Pragma("unroll") for (int n = 0; n < 2; ++n) _Pragma("unroll") for (int k = 0; k < 2; ++k) \
        acc[ai][bj][m][n] = __builtin_amdgcn_mfma_f32_16x16x32_bf16(Bt[n][k], At[m][k], acc[ai][bj][m][n], 0, 0, 0); __builtin_amdgcn_s_setprio(0); } while (0)
#define PG8_WAIT_V(n) asm volatile("s_waitcnt vmcnt(" #n ")" ::: "memory")
#define PG8_WAIT_L(n) asm volatile("s_waitcnt lgkmcnt(" #n ")" ::: "memory")
#define PG8_BAR __builtin_amdgcn_s_barrier()
#define PG8_SCHED __builtin_amdgcn_sched_barrier(0)
    Unit cur, nxt; int ui = 0;
    if (!S.next(0, cur)) return;
    f32x4 acc[2][2][4][2];
#pragma unroll
    for (int a = 0; a < 2; ++a)
#pragma unroll
        for (int b = 0; b < 2; ++b)
#pragma unroll
            for (int m = 0; m < 4; ++m)
#pragma unroll
                for (int n = 0; n < 2; ++n) acc[a][b][m][n] = (f32x4){0.f, 0.f, 0.f, 0.f};
    bf16x8 At[4][2], B0[2][2], B1[2][2];
    const char* cA = (const char*)g.A + (size_t)cur.pm * tstep; const char* cB = (const char*)g.Bt + (size_t)cur.pn * tstep;
    S.a_ready(cur);
    if constexpr (SP2) {
        PG8_STAGE(PG8_SB(0, 0), cB, voffB); PG8_STAGE(PG8_SB(0, 1), cB + hstep, voffB); PG8_STAGE(PG8_SA(0, 0), cA, voffA); PG8_STAGE(PG8_SA(0, 1), cA + hstep, voffA);
        if (wr == 1) PG8_BAR;
        PG8_WAIT_V(2); PG8_BAR;
        PG8_STAGE(PG8_SB(1, 0), cB + kstep, voffB); PG8_STAGE(PG8_SA(1, 0), cA + kstep, voffA); PG8_STAGE(PG8_SB(1, 1), cB + hstep + kstep, voffB);
        PG8_WAIT_V(6); PG8_BAR;
    } else {
        PG8_STAGE(PG8_SB(0, 0), cB, voffB); PG8_STAGE(PG8_SA(0, 0), cA, voffA); PG8_STAGE(PG8_SB(0, 1), cB + hstep, voffB); PG8_STAGE(PG8_SA(0, 1), cA + hstep, voffA);
        if (wr == 1) PG8_BAR;
        PG8_WAIT_V(4); PG8_BAR;
        PG8_STAGE(PG8_SB(1, 0), cB + kstep, voffB); PG8_STAGE(PG8_SA(1, 0), cA + kstep, voffA); PG8_STAGE(PG8_SB(1, 1), cB + hstep + kstep, voffB);
        PG8_WAIT_V(6); PG8_BAR;
    }
    for (;;) {
        const bool has_next = S.next(ui + 1, nxt);
        const char* nA = has_next ? (const char*)g.A + (size_t)nxt.pm * tstep : cA; const char* nB = has_next ? (const char*)g.Bt + (size_t)nxt.pn * tstep : cB;
        for (int t = 0; t < nt; t += 2) {
            const bool last = (t == nt - 2);
            const char* a1 = cA + (size_t)(t + 1) * kstep;
            const char* a2 = last ? nA : cA + (size_t)(t + 2) * kstep; const char* b2 = last ? nB : cB + (size_t)(t + 2) * kstep;
            const char* a3 = a2 + kstep; const char* b3 = b2 + kstep;
            if (last && has_next) S.a_ready(nxt);
            if constexpr (SP2) {
            PG8_LDB(B0, 0, 0); PG8_LDB(B1, 0, 1); PG8_SCHED; PG8_LDA(At, 0, 0); PG8_STAGE(PG8_SA(1, 1), a1 + hstep, voffA);
            PG8_WAIT_V(8); PG8_WAIT_L(0); PG8_BAR; PG8_MMA(0, 0, At, B0); PG8_MMA(0, 1, At, B1); PG8_BAR; PG8_SCHED;
            PG8_LDA(At, 0, 1); PG8_STAGE(PG8_SB(0, 0), b2, voffB); PG8_STAGE(PG8_SB(0, 1), b2 + hstep, voffB); PG8_STAGE(PG8_SA(0, 0), a2, voffA);
            PG8_WAIT_V(8); PG8_WAIT_L(0); PG8_BAR; PG8_MMA(1, 0, At, B0); PG8_MMA(1, 1, At, B1); PG8_BAR; PG8_SCHED;
            PG8_LDB(B0, 1, 0); PG8_LDB(B1, 1, 1); PG8_SCHED; PG8_LDA(At, 1, 0); PG8_STAGE(PG8_SA(0, 1), a2 + hstep, voffA);
            PG8_WAIT_V(8); PG8_WAIT_L(0); PG8_BAR; PG8_MMA(0, 0, At, B0); PG8_MMA(0, 1, At, B1); PG8_BAR; PG8_SCHED;
            PG8_LDA(At, 1, 1); PG8_STAGE(PG8_SB(1, 0), b3, voffB); PG8_STAGE(PG8_SB(1, 1), b3 + hstep, voffB); PG8_STAGE(PG8_SA(1, 0), a3, voffA);
            PG8_WAIT_V(8); PG8_WAIT_L(0); PG8_BAR; PG8_MMA(1, 0, At, B0); PG8_MMA(1, 1, At, B1); PG8_BAR; PG8_SCHED;
            } else {
            PG8_LDB(B0, 0, 0); PG8_SCHED; PG8_LDA(At, 0, 0); PG8_STAGE(PG8_SA(1, 1), a1 + hstep, voffA);
            PG8_WAIT_L(8); PG8_BAR; PG8_WAIT_L(0); PG8_MMA(0, 0, At, B0); PG8_BAR; PG8_SCHED;
            PG8_LDB(B1, 0, 1); PG8_STAGE(PG8_SB(0, 0), b2, voffB);
            PG8_BAR; PG8_WAIT_L(0); PG8_MMA(0, 1, At, B1); PG8_BAR;
            PG8_LDA(At, 0, 1); PG8_STAGE(PG8_SA(0, 0), a2, voffA);
            PG8_BAR; PG8_WAIT_L(0); PG8_MMA(1, 0, At, B0); PG8_BAR; PG8_SCHED;
            PG8_STAGE(PG8_SB(0, 1), b2 + hstep, voffB);
            PG8_WAIT_V(6); PG8_BAR; PG8_MMA(1, 1, At, B1); PG8_BAR;
            PG8_LDB(B0, 1, 0); PG8_SCHED; PG8_LDA(At, 1, 0); PG8_STAGE(PG8_SA(0, 1), a2 + hstep, voffA);
            PG8_WAIT_L(8); PG8_BAR; PG8_WAIT_L(0); PG8_MMA(0, 0, At, B0); PG8_BAR; PG8_SCHED;
            PG8_LDB(B1, 1, 1); PG8_STAGE(PG8_SB(1, 0), b3, voffB);
            PG8_BAR; PG8_WAIT_L(0); PG8_MMA(0, 1, At, B1); PG8_BAR;
            PG8_LDA(At, 1, 1); PG8_STAGE(PG8_SA(1, 0), a3, voffA);
            PG8_BAR; PG8_WAIT_L(0); PG8_MMA(1, 0, At, B0); PG8_BAR; PG8_SCHED;
            PG8_STAGE(PG8_SB(1, 1), b3 + hstep, voffB);
            PG8_WAIT_V(6); PG8_BAR; PG8_MMA(1, 1, At, B1); PG8_BAR;
            }
        }
        if constexpr (ALIGN_EPI) { if (wr == 0) PG8_BAR; }
        if constexpr (!Epi::AFTER_DRAIN) { E(acc, cur, wr, wc, fr, fq); S.done(cur); }
        if (!has_next) break;
#pragma unroll
        for (int a = 0; a < 2; ++a)
#pragma unroll
            for (int b = 0; b < 2; ++b)
#pragma unroll
                for (int m = 0; m < 4; ++m)
#pragma unroll
                    for (int n = 0; n < 2; ++n) acc[a][b][m][n] = (f32x4){0.f, 0.f, 0.f, 0.f};
        cur = nxt; cA = nA; cB = nB; ++ui;
        if constexpr (ALIGN_EPI) { if (wr == 1) PG8_BAR; }
    }
    PG8_WAIT_V(0);
    if constexpr (!ALIGN_EPI) { if (wr == 0) PG8_BAR; }
    PG8_BAR;
    if constexpr (Epi::AFTER_DRAIN) { E.fused(acc, cur, wr, wc, fr, fq, lds, wid, lane); S.done(cur); }
#undef PG8_SA
#undef PG8_SB
#undef PG8_STAGE
#undef PG8_LDA
#undef PG8_LDB
#undef PG8_MMA
#undef PG8_WAIT_V
#undef PG8_WAIT_L
#undef PG8_BAR
#undef PG8_SCHED
}
}

#ifndef DBG
#define DBG 0
#endif
#define DI __device__ __forceinline__
#define LAS __attribute__((address_space(3)))
typedef unsigned short bf16;
typedef unsigned v4u __attribute__((ext_vector_type(4)));
typedef unsigned v2u __attribute__((ext_vector_type(2)));
typedef float f32x4 __attribute__((ext_vector_type(4)));
typedef float f32x2 __attribute__((ext_vector_type(2)));
typedef float f32x16 __attribute__((ext_vector_type(16)));
typedef short bf16x8 __attribute__((ext_vector_type(8)));
typedef __bf16 bfv2 __attribute__((ext_vector_type(2)));

constexpr int T = 32768, DM = 1024, SEQ = 4096, NB = 8, DPLE = 256;
constexpr int INC = 3080;
constexpr float EPS = 1e-6f;
constexpr size_t MiB = 1u << 20;
constexpr size_t WS_CTL = 0;
constexpr size_t WS_WAIF = 1 * MiB;
constexpr size_t WS_WRT = 1 * MiB + 256 * 1024;
constexpr size_t WS_BA = 2 * MiB;
constexpr size_t WS_SUM = 3 * MiB;
constexpr size_t WS_GL = 5 * MiB;
constexpr size_t WS_DBGBUF = 5 * MiB + 64 * 1024;
constexpr size_t WS_TOK = 6 * MiB;
constexpr size_t WS_SLOTG = 7 * MiB;
constexpr size_t WS_TILE = 7 * MiB + 512 * 1024;
constexpr size_t WS_WINT = 8 * MiB, WS_WOUTT = 14 * MiB, WS_WPGT = 16 * MiB, WS_WPT = 18 * MiB;
constexpr size_t WS_PB = 20 * MiB;
constexpr size_t WS_XN1 = 36 * MiB, WS_PH = 36 * MiB, WS_WDT = 36 * MiB;
constexpr size_t WS_PROJ = 100 * MiB;
constexpr size_t WS_Y = 164 * MiB;
constexpr size_t WS_XS = 68 * MiB, WS_YB = 68 * MiB;
constexpr size_t WS_WGUT = 228 * MiB, WS_XN3 = 228 * MiB;
constexpr size_t WS_GOP = 292 * MiB, WS_H1 = 292 * MiB;
constexpr size_t WS_O = 436 * MiB, WS_XN2 = 436 * MiB, WS_HB = 436 * MiB, WS_PE = 436 * MiB;
constexpr size_t WS_END = 508 * MiB;
constexpr int GOP_ITEM = 73728;
constexpr int LDS_BYTES = 147456;

#define LDS_WAIT() asm volatile("s_waitcnt lgkmcnt(0)" ::: "memory")
DI unsigned pk2(float lo, float hi) { bfv2 v; v[0] = (__bf16)lo; v[1] = (__bf16)hi; return __builtin_bit_cast(unsigned, v); }
DI float bf_lo(unsigned u) { return __uint_as_float(u << 16); }
DI float bf_hi(unsigned u) { return __uint_as_float(u & 0xffff0000u); }
DI float bf2f(bf16 b) { return __uint_as_float(((unsigned)b) << 16); }
DI bf16 f2bf(float f) { return (bf16)(pk2(f, 0.f) & 0xffffu); }
DI float wave_sum(float v) {
#pragma unroll
    for (int o = 1; o < 64; o <<= 1) v += __shfl_xor(v, o);
    return v;
}
DI float sigmoidf_(float x) { return 1.f / (1.f + __expf(-x)); }
DI float siluf_(float x) { return x / (1.f + __expf(-x)); }
DI float geluf_(float x) { const float u = 1.5957691216f * (x + 0.044715f * x * x * x); return x / (1.f + __expf(-u)); }
DI unsigned ld_u32(const unsigned* p) { return __hip_atomic_load(p, __ATOMIC_RELAXED, __HIP_MEMORY_SCOPE_AGENT); }
DI float ld_f32(const float* p) { return __uint_as_float(__hip_atomic_load((const unsigned*)p, __ATOMIC_RELAXED, __HIP_MEMORY_SCOPE_AGENT)); }
#define MFMA16(a, b, c) __builtin_amdgcn_mfma_f32_16x16x32_bf16((a), (b), (c), 0, 0, 0)
#define MFMA32(a, b, c) __builtin_amdgcn_mfma_f32_32x32x16_bf16((a), (b), (c), 0, 0, 0)
DI bf16x8 pack8(const float* a) { v4u p; p.x = pk2(a[0], a[1]); p.y = pk2(a[2], a[3]); p.z = pk2(a[4], a[5]); p.w = pk2(a[6], a[7]); return __builtin_bit_cast(bf16x8, p); }
template <int S_> DI bf16x8 pack_step(const f32x16& x) { v4u p; p.x = pk2(x[8 * S_ + 0], x[8 * S_ + 1]); p.y = pk2(x[8 * S_ + 2], x[8 * S_ + 3]); p.z = pk2(x[8 * S_ + 4], x[8 * S_ + 5]); p.w = pk2(x[8 * S_ + 6], x[8 * S_ + 7]); return __builtin_bit_cast(bf16x8, p); }

struct Params { const float* in[29]; float* out; unsigned char* ws; int ph_lo, ph_hi; };

DI void transpose_item(const float* __restrict__ W, int ldw, const float* __restrict__ gain, bf16* WT, int ldt, int dst_row0, int k0, int n0, LAS float* scr_, int lane) {
    LAS unsigned* scr = (LAS unsigned*)scr_;
    const int q = lane & 7, kr = lane >> 3;
    f32x4 v0[4], v1[4]; float g0[4], g1[4];
#pragma unroll
    for (int i = 0; i < 4; ++i) { const int k = k0 + 16 * i + 2 * kr;
        v0[i] = *(const f32x4*)(W + (size_t)k * ldw + n0 + 4 * q); v1[i] = *(const f32x4*)(W + (size_t)(k + 1) * ldw + n0 + 4 * q);
        g0[i] = gain ? gain[k] : 1.f; g1[i] = gain ? gain[k + 1] : 1.f; }
#pragma unroll
    for (int i = 0; i < 4; ++i)
#pragma unroll
        for (int e = 0; e < 4; ++e) scr[(4 * q + e) * 33 + 8 * i + kr] = pk2(v0[i][e] * g0[i], v1[i][e] * g1[i]);
    LDS_WAIT(); asm volatile("" ::: "memory");
    const int c = lane & 7;
#pragma unroll
    for (int j = 0; j < 4; ++j) { const int n = (lane >> 3) + 8 * j; const LAS unsigned* s = scr + n * 33 + 4 * c;
        v4u o; o.x = s[0]; o.y = s[1]; o.z = s[2]; o.w = s[3];
        *(v4u*)(WT + (size_t)(dst_row0 + n) * ldt + k0 + 8 * c) = o; }
    LDS_WAIT(); asm volatile("" ::: "memory");
}

DI void phase0(const Params& P, LAS unsigned char* lds, int tid, int lane, int wid, int gw, int NGW) {
    unsigned char* ws = P.ws;
    const float* x = P.in[0]; const float* p = P.in[1]; const float* norm_mix = P.in[2]; const float* w_in = P.in[3];
    LAS float* scr = (LAS float*)(lds + wid * 8448);
    LAS float* Wba = (LAS float*)(lds + 73728);
    for (int e = tid; e < 8192; e += 512) { const int k = e >> 3, j = e & 7; Wba[e] = w_in[(size_t)k * INC + 3072 + j] * norm_mix[k]; }
    for (int it = gw; it < 2688; it += NGW) {
        int r = it;
        if (r < 1536) { const int kb = r / 96, nb = r % 96; transpose_item(w_in, INC, norm_mix, (bf16*)(ws + WS_WINT), 1024, 32 * nb, 64 * kb, 32 * nb, scr, lane); continue; } r -= 1536;
        if (r < 512) { const int kb = r >> 5, nb = r & 31; transpose_item(P.in[16], 1024, nullptr, (bf16*)(ws + WS_WOUTT), 1024, 32 * nb, 64 * kb, 32 * nb, scr, lane); continue; } r -= 512;
        if (r < 512) { const int kb = r >> 5, nb = r & 31; transpose_item(P.in[26], 1024, P.in[25], (bf16*)(ws + WS_WPGT), 1024, 32 * nb, 64 * kb, 32 * nb, scr, lane); continue; } r -= 512;
        { const int kb = r >> 5, nb = r & 31; transpose_item(P.in[27], 1024, nullptr, (bf16*)(ws + WS_WPT), 256, 32 * nb, 64 * kb, 32 * nb, scr, lane); }
    }
    { bf16* WAIF = (bf16*)(ws + WS_WAIF); const float* wa = P.in[6]; const float* wi = P.in[8];
      for (int e = gw * 64 + lane; e < 65536; e += NGW * 64) { const int j = e & 7, ln = (e >> 3) & 63, kk = (e >> 9) & 1, nt = (e >> 10) & 7, cb = e >> 13;
          const int fr = ln & 15, fq = ln >> 4, c = 32 * kk + 8 * fq + j, d = 16 * (nt & 3) + fr;
          WAIF[e] = f2bf((nt < 4 ? wa : wi)[(cb * 64 + c) * 64 + d]); } }
    { float* WRT = (float*)(ws + WS_WRT); const float* nf = P.in[17]; const float* wrg = P.in[18]; const float* wre = P.in[20];
      for (int e = gw * 64 + lane; e < 36 * 1024; e += NGW * 64) { const int c = e >> 10, k = e & 1023; WRT[e] = (c < 4 ? wrg[k * 4 + c] : wre[k * 32 + (c - 4)]) * nf[k]; } }
    { const f32x4* p4 = (const f32x4*)p; v4u* pb = (v4u*)(ws + WS_PB);
      for (int i = gw * 64 + lane; i < T * DPLE / 8; i += NGW * 64) { const f32x4 a = p4[2 * i], b = p4[2 * i + 1]; v4u o; o.x = pk2(a.x, a.y); o.y = pk2(a.z, a.w); o.z = pk2(b.x, b.y); o.w = pk2(b.z, b.w); pb[i] = o; } }
    __syncthreads();
    { bf16* XN1 = (bf16*)(ws + WS_XN1); float* BA = (float*)(ws + WS_BA);
      for (int t = gw; t < T; t += NGW) {
          const f32x4* xr = (const f32x4*)(x + (size_t)t * DM);
          f32x4 v[4]; float ss = 0.f;
#pragma unroll
          for (int j = 0; j < 4; ++j) { v[j] = xr[lane + 64 * j]; ss += (v[j].x * v[j].x + v[j].y * v[j].y) + (v[j].z * v[j].z + v[j].w * v[j].w); }
          const float rs = rsqrtf(wave_sum(ss) * (1.f / DM) + EPS);
          float acc[8];
#pragma unroll
          for (int c = 0; c < 8; ++c) acc[c] = 0.f;
#pragma unroll
          for (int j = 0; j < 4; ++j) {
              const int k4 = 4 * (lane + 64 * j);
              *(v2u*)(XN1 + (size_t)t * DM + k4) = (v2u){pk2(v[j].x * rs, v[j].y * rs), pk2(v[j].z * rs, v[j].w * rs)};
#pragma unroll
              for (int e = 0; e < 4; ++e) { const f32x4 w0 = *(const LAS f32x4*)(Wba + (k4 + e) * 8), w1 = *(const LAS f32x4*)(Wba + (k4 + e) * 8 + 4); const float xv = v[j][e];
                  acc[0] += xv * w0.x; acc[1] += xv * w0.y; acc[2] += xv * w0.z; acc[3] += xv * w0.w; acc[4] += xv * w1.x; acc[5] += xv * w1.y; acc[6] += xv * w1.z; acc[7] += xv * w1.w; }
          }
#pragma unroll
          for (int c = 0; c < 8; ++c) acc[c] = wave_sum(acc[c]) * rs;
          if (lane == 0) { *(f32x4*)(BA + (size_t)t * 8) = (f32x4){acc[0], acc[1], acc[2], acc[3]}; *(f32x4*)(BA + (size_t)t * 8 + 4) = (f32x4){acc[4], acc[5], acc[6], acc[7]}; }
      } }
    __syncthreads();
}

struct EpiRes {
    static constexpr bool PERM = false, AFTER_DRAIN = false;
    float* C; const float* R;
    DI void operator()(const pg8::f32x4 (&acc)[2][2][4][2], const pg8::Unit& u, int wr, int wc, int fr, int fq) const {
        const int row0 = u.pm * 256 + wr * 64 + fr, col0 = u.pn * 256 + wc * 32 + 4 * fq;
#pragma unroll
        for (int ai = 0; ai < 2; ++ai)
#pragma unroll
            for (int m = 0; m < 4; ++m) { const size_t off = (size_t)(row0 + ai * 128 + m * 16) * DM + col0;
#pragma unroll
                for (int bj = 0; bj < 2; ++bj)
#pragma unroll
                    for (int n = 0; n < 2; ++n) { const size_t o = off + bj * 128 + n * 16; *(f32x4*)(C + o) = acc[ai][bj][m][n] + *(const f32x4*)(R + o); } }
    }
};
struct EpiSwiglu {
    static constexpr bool PERM = true, AFTER_DRAIN = false;
    bf16* HB;
    DI void operator()(const pg8::f32x4 (&acc)[2][2][4][2], const pg8::Unit& u, int wr, int wc, int fr, int fq) const {
        const int row0 = u.pm * 256 + wr * 64 + fr, colh = (u.pn & 3) * 128 + wc * 32 + 8 * fq;
#pragma unroll
        for (int ai = 0; ai < 2; ++ai)
#pragma unroll
            for (int m = 0; m < 4; ++m) { bf16* rowp = HB + (size_t)(row0 + ai * 128 + m * 16) * 512 + colh;
                float v[8];
#pragma unroll
                for (int n = 0; n < 2; ++n)
#pragma unroll
                    for (int e = 0; e < 4; ++e) { const float g = acc[ai][0][m][n][e], up = acc[ai][1][m][n][e]; v[4 * n + e] = siluf_(g) * up; }
                v4u w; w.x = pk2(v[0], v[1]); w.y = pk2(v[2], v[3]); w.z = pk2(v[4], v[5]); w.w = pk2(v[6], v[7]);
                *(v4u*)rowp = w; }
    }
};
struct EpiDown {
    static constexpr bool PERM = true, AFTER_DRAIN = false;
    bf16* YB; const float* slotg;
    DI void operator()(const pg8::f32x4 (&acc)[2][2][4][2], const pg8::Unit& u, int wr, int wc, int fr, int fq) const {
        const int row0 = u.pm * 256 + wr * 64 + fr, col0 = (u.pn & 3) * 256 + wc * 32 + 8 * fq;
#pragma unroll
        for (int ai = 0; ai < 2; ++ai)
#pragma unroll
            for (int m = 0; m < 4; ++m) { const int row = row0 + ai * 128 + m * 16; const float gwt = slotg[row]; bf16* rowp = YB + (size_t)row * DM + col0;
#pragma unroll
                for (int bj = 0; bj < 2; ++bj) { const pg8::f32x4 v0 = acc[ai][bj][m][0] * gwt, v1 = acc[ai][bj][m][1] * gwt;
                    v4u w; w.x = pk2(v0[0], v0[1]); w.y = pk2(v0[2], v0[3]); w.z = pk2(v1[0], v1[1]); w.w = pk2(v1[2], v1[3]);
                    *(v4u*)(rowp + bj * 128) = w; } }
    }
};
struct EpiPle {
    static constexpr bool PERM = false, AFTER_DRAIN = false;
    float* H; const bf16* PE; float* RS4; bool commit;
    DI void operator()(const pg8::f32x4 (&acc)[2][2][4][2], const pg8::Unit& u, int wr, int wc, int fr, int fq) const {
        const int row0 = u.pm * 256 + wr * 64 + fr, col0 = u.pn * 256 + wc * 32 + 4 * fq;
#pragma unroll
        for (int ai = 0; ai < 2; ++ai)
#pragma unroll
            for (int m = 0; m < 4; ++m) { const int row = row0 + ai * 128 + m * 16; const size_t off = (size_t)row * DM + col0; float ss = 0.f;
#pragma unroll
                for (int bj = 0; bj < 2; ++bj)
#pragma unroll
                    for (int n = 0; n < 2; ++n) { const size_t o = off + bj * 128 + n * 16; const f32x4 h2 = *(const f32x4*)(H + o); const v2u pe = *(const v2u*)(PE + o);
                        const pg8::f32x4 a = acc[ai][bj][m][n]; f32x4 h3;
                        h3.x = h2.x + bf_lo(pe.x) * sigmoidf_(a[0]); h3.y = h2.y + bf_hi(pe.x) * sigmoidf_(a[1]); h3.z = h2.z + bf_lo(pe.y) * sigmoidf_(a[2]); h3.w = h2.w + bf_hi(pe.y) * sigmoidf_(a[3]);
                        if (commit) *(f32x4*)(H + o) = h3; ss += (h3.x * h3.x + h3.y * h3.y) + (h3.z * h3.z + h3.w * h3.w); }
                ss += __shfl_xor(ss, 16); ss += __shfl_xor(ss, 32);
                if (fq == 0 && commit) atomicAdd(RS4 + row, ss); asm volatile("" :: "v"(ss)); }
    }
};
struct MoeSched {
    const unsigned* tile_e; int nU, G, c;
    DI bool next(int i, pg8::Unit& u) const { const int L = i * G + c; if (L >= nU) return false; const int pm = L >> 2;
        u.pm = pm; u.pn = (int)__builtin_amdgcn_readfirstlane(ld_u32(tile_e + pm)) * 4 + (L & 3); return true; }
    DI void a_ready(const pg8::Unit&) const {}
    DI void done(const pg8::Unit&) const {}
};
#define XB_TMO      128
#define XB_XCNT(j)  (256  + 64 * (j))
#define XB_XSUB(j)  (1280 + 64 * (j))
#define XB_XGEN(j)  (2304 + 64 * (j))
#define XB_TOP      3328
#define XB_TOPGEN   3392
#define XCD_BAR_WORDS 3456
#define XB_SPIN_CAP (1u << 18)

__device__ __forceinline__ unsigned xb_ld(unsigned* p)              { return __hip_atomic_load(p, __ATOMIC_RELAXED, __HIP_MEMORY_SCOPE_AGENT); }
__device__ __forceinline__ unsigned xb_add(unsigned* p, unsigned v) { return __hip_atomic_fetch_add(p, v, __ATOMIC_RELAXED, __HIP_MEMORY_SCOPE_AGENT); }
__device__ __forceinline__ unsigned xb_xcc_id() { return (unsigned)__builtin_amdgcn_s_getreg((3 << 11) | 20) & 0xFu; }
#define XB_SPIN(cond, bar) do { unsigned _sp = 0; while (cond) { __builtin_amdgcn_s_sleep(1); \
    if ((++_sp & 255u) == 0u) { if (xb_ld(&(bar)[XB_TMO])) break; if (_sp > XB_SPIN_CAP) { atomicAdd(&(bar)[XB_TMO], 1u); break; } } } } while (0)

struct XcdBarrier {
    unsigned* bar; unsigned x;
    volatile LAS unsigned* st;
};

__device__ __forceinline__ XcdBarrier xcd_barrier_post(unsigned* bar, volatile LAS unsigned* st) {
    XcdBarrier b; b.bar = bar; b.x = xb_xcc_id(); b.st = st;
    if (threadIdx.x == 0) (void)xb_add(&bar[XB_XCNT(b.x)], 1u);
    return b;
}
__device__ __forceinline__ void xcd_barrier_complete(unsigned* bar, unsigned x, unsigned& nloc, unsigned& nx) {
    const unsigned G = gridDim.x * gridDim.y * gridDim.z;
    unsigned sum, cnt, mine, sp = 0u;
    for (;;) {
        sum = 0u; cnt = 0u; mine = 0u;
#pragma unroll
        for (unsigned j = 0; j < 16; ++j) { const unsigned c = xb_ld(&bar[XB_XCNT(j)]); sum += c; cnt += (c > 0u) ? 1u : 0u; mine = (j == x) ? c : mine; }
        if (sum == G) break;
        __builtin_amdgcn_s_sleep(1);
        if ((++sp & 255u) == 0u) { if (xb_ld(&bar[XB_TMO])) break; if (sp > XB_SPIN_CAP) { atomicAdd(&bar[XB_TMO], 1u); break; } }
    }
    nloc = mine > 0u ? mine : 1u; nx = cnt > 0u ? cnt : 1u;
}

__device__ __forceinline__ void xcd_barrier(const XcdBarrier& b) {
    asm volatile("s_waitcnt vmcnt(0)" ::: "memory");
    __syncthreads();
    if (threadIdx.x == 0) {
        unsigned* bar = b.bar;
        __builtin_amdgcn_s_waitcnt(0);
        unsigned nloc = b.st[0], nx = b.st[1];
        if (nloc == 0u) { xcd_barrier_complete(bar, b.x, nloc, nx); b.st[0] = nloc; b.st[1] = nx; }
        const unsigned old = xb_add(&bar[XB_XSUB(b.x)], 1u);
        const unsigned gen = old / nloc;
        if (old + 1u == (gen + 1u) * nloc) {
            __builtin_amdgcn_fence(__ATOMIC_RELEASE, "agent");
            asm volatile("s_waitcnt vmcnt(0)" ::: "memory");
            const unsigned og = xb_add(&bar[XB_TOP], 1u);
            const unsigned tg = og / nx;
            if (og + 1u == (tg + 1u) * nx) xb_add(&bar[XB_TOPGEN], 1u);
            else XB_SPIN(xb_ld(&bar[XB_TOPGEN]) == tg, bar);
            __builtin_amdgcn_fence(__ATOMIC_ACQUIRE, "agent");
            xb_add(&bar[XB_XGEN(b.x)], 1u);
            asm volatile("s_waitcnt vmcnt(0)" ::: "memory");
        } else {
            XB_SPIN(xb_ld(&bar[XB_XGEN(b.x)]) == gen, bar);
            __builtin_amdgcn_fence(__ATOMIC_ACQUIRE, "agent");
            asm volatile("s_waitcnt vmcnt(0)" ::: "memory");
        }
    }
    __syncthreads();
}

DI void lru_item(int bi, const bf16* LX, const float* conv_w, const float* conv_b, const bf16* WAIF, const float* ba, const float* bi_, const float* lam,
                 float* SUM, unsigned* PH, LAS unsigned char* lds, int tid, int lane, int wid) {
    asm volatile("" : "+v"(lane), "+v"(tid));
    const int n = bi & 63, b = bi >> 6, t0 = b * SEQ + 64 * n;
    LAS bf16* XT = (LAS bf16*)lds; LAS float* CW = (LAS float*)(lds + 69696);
    for (int p = tid; p < 67 * 64; p += 512) { const int r = p >> 6, c16 = p & 63, tok = r - 3; v4u v = (v4u){0u, 0u, 0u, 0u};
        if (n * 64 + tok >= 0) v = *(const v4u*)(LX + (size_t)(t0 + tok) * 512 + c16 * 8);
        *(LAS v4u*)(XT + r * 520 + c16 * 8) = v; }
    for (int e = tid; e < 2560; e += 512) CW[e] = e < 2048 ? conv_w[e] : conv_b[e - 2048];
    __syncthreads();
    const int cb = wid, fr = lane & 15, fq = lane >> 4;
    const bf16x8* bfp = (const bf16x8*)(WAIF + (size_t)cb * 8192) + lane;
    float lsl[4], bav[4], biv[4], cw[4][4], cbv[4], h[4], Apr[4];
#pragma unroll
    for (int c = 0; c < 4; ++c) { const int d = 64 * cb + 16 * c + fr; const float lm = lam[d]; lsl[c] = -8.f * log1pf(__expf(-lm)); bav[c] = ba[d]; biv[c] = bi_[d];
#pragma unroll
        for (int tp = 0; tp < 4; ++tp) cw[tp][c] = CW[tp * 512 + d];
        cbv[c] = CW[2048 + d]; h[c] = 0.f; Apr[c] = 1.f; }
#pragma unroll 1
    for (int m = 0; m < 4; ++m) {
        bf16x8 afrag[2];
#pragma unroll
        for (int kk = 0; kk < 2; ++kk) { const int c8 = 64 * cb + 32 * kk + 8 * fq; float a8[8];
            { const f32x4 b0 = *(const LAS f32x4*)(CW + 2048 + c8), b1 = *(const LAS f32x4*)(CW + 2048 + c8 + 4); a8[0] = b0.x; a8[1] = b0.y; a8[2] = b0.z; a8[3] = b0.w; a8[4] = b1.x; a8[5] = b1.y; a8[6] = b1.z; a8[7] = b1.w; }
#pragma unroll
            for (int tp = 0; tp < 4; ++tp) { const v4u xv = *(const LAS v4u*)(XT + (16 * m + fr + tp) * 520 + c8);
                const f32x4 w0 = *(const LAS f32x4*)(CW + tp * 512 + c8), w1 = *(const LAS f32x4*)(CW + tp * 512 + c8 + 4);
                a8[0] += w0.x * bf_lo(xv.x); a8[1] += w0.y * bf_hi(xv.x); a8[2] += w0.z * bf_lo(xv.y); a8[3] += w0.w * bf_hi(xv.y);
                a8[4] += w1.x * bf_lo(xv.z); a8[5] += w1.y * bf_hi(xv.z); a8[6] += w1.z * bf_lo(xv.w); a8[7] += w1.w * bf_hi(xv.w); }
            afrag[kk] = pack8(a8); }
        f32x4 acc[8];
#pragma unroll
        for (int nt = 0; nt < 8; ++nt) { const bf16x8 b0 = bfp[(nt * 2) * 64], b1 = bfp[(nt * 2 + 1) * 64]; acc[nt] = (f32x4){0.f, 0.f, 0.f, 0.f}; acc[nt] = MFMA16(afrag[0], b0, acc[nt]); acc[nt] = MFMA16(afrag[1], b1, acc[nt]); }
        __builtin_amdgcn_sched_barrier(0);
#pragma unroll
        for (int c = 0; c < 4; ++c) {
            const int dl = 64 * cb + 16 * c + fr;
            float av[4], uv[4];
#pragma unroll
            for (int rg = 0; rg < 4; ++rg) { const int tok = 16 * m + 4 * fq + rg;
                const float r_ = sigmoidf_(acc[c][rg] + bav[c]), i_ = sigmoidf_(acc[4 + c][rg] + biv[c]);
                const float a = __expf(r_ * lsl[c]);
                float xc = cbv[c];
#pragma unroll
                for (int tp = 0; tp < 4; ++tp) xc += cw[tp][c] * bf2f(XT[(tok + tp) * 520 + dl]);
                av[rg] = a; uv[rg] = sqrtf(fmaxf(1.f - a * a, 0.f)) * (i_ * xc); }
            float Al = 1.f, Ul = 0.f;
#pragma unroll
            for (int rg = 0; rg < 4; ++rg) { Ul = av[rg] * Ul + uv[rg]; Al = av[rg] * Al; }
            float hin = h[c], hnext = h[c], pin = Apr[c], Atot = 1.f;
#pragma unroll
            for (int q = 0; q < 4; ++q) { const float Aq = __shfl(Al, fr + 16 * q), Uq = __shfl(Ul, fr + 16 * q);
                hin = (q < fq) ? Aq * hin + Uq : hin; pin = (q < fq) ? pin * Aq : pin; hnext = Aq * hnext + Uq; Atot *= Aq; }
#pragma unroll
            for (int rg = 0; rg < 4; ++rg) { const int tok = 16 * m + 4 * fq + rg; hin = av[rg] * hin + uv[rg]; pin *= av[rg];
                PH[(size_t)(t0 + tok) * 512 + dl] = pk2(pin, hin); }
            h[c] = hnext; Apr[c] *= Atot;
            __builtin_amdgcn_sched_barrier(0);
        }
    }
    if (fq == 0) {
#pragma unroll
        for (int c = 0; c < 4; ++c) { const int d = 64 * cb + 16 * c + fr; *(f32x2*)(SUM + ((size_t)(b * 64 + n) * 512 + d) * 2) = (f32x2){Apr[c], h[c]}; } }
    __syncthreads();
}

DI void lru_fin_item(int bi, const unsigned* PH, const bf16* LG, const float* SUM, const float* out_g, bf16* Y, LAS unsigned char* lds, int tid, int lane, int wid) {
    asm volatile("" : "+v"(lane), "+v"(tid));
    const int n = bi & 63, b = bi >> 6, t0 = b * SEQ + 64 * n;
    LAS float* CAR = (LAS float*)lds;
    { float hc = 0.f; const f32x2* sp = (const f32x2*)SUM + (size_t)(b * 64) * 512 + tid; int k = 0;
      for (; k + 8 <= n; k += 8) { f32x2 s[8];
#pragma unroll
          for (int q = 0; q < 8; ++q) s[q] = sp[(size_t)(k + q) * 512];
#pragma unroll
          for (int q = 0; q < 8; ++q) hc = s[q].x * hc + s[q].y; }
      for (; k < n; ++k) { const f32x2 s = sp[(size_t)k * 512]; hc = s.x * hc + s.y; }
      CAR[tid] = hc; }
    __syncthreads();
    const int c0 = 8 * lane;
    float car[8], og[8];
#pragma unroll
    for (int e = 0; e < 8; ++e) { car[e] = CAR[c0 + e]; og[e] = out_g[c0 + e]; }
#pragma unroll 2
    for (int i = 0; i < 8; ++i) { const int t = t0 + 8 * wid + i;
        const v4u p0 = *(const v4u*)(PH + (size_t)t * 512 + c0), p1 = *(const v4u*)(PH + (size_t)t * 512 + c0 + 4); const v4u g = *(const v4u*)(LG + (size_t)t * 512 + c0);
        float v[8];
        v[0] = (bf_hi(p0.x) + bf_lo(p0.x) * car[0]) * geluf_(bf_lo(g.x)); v[1] = (bf_hi(p0.y) + bf_lo(p0.y) * car[1]) * geluf_(bf_hi(g.x));
        v[2] = (bf_hi(p0.z) + bf_lo(p0.z) * car[2]) * geluf_(bf_lo(g.y)); v[3] = (bf_hi(p0.w) + bf_lo(p0.w) * car[3]) * geluf_(bf_hi(g.y));
        v[4] = (bf_hi(p1.x) + bf_lo(p1.x) * car[4]) * geluf_(bf_lo(g.z)); v[5] = (bf_hi(p1.y) + bf_lo(p1.y) * car[5]) * geluf_(bf_hi(g.z));
        v[6] = (bf_hi(p1.z) + bf_lo(p1.z) * car[6]) * geluf_(bf_lo(g.w)); v[7] = (bf_hi(p1.w) + bf_lo(p1.w) * car[7]) * geluf_(bf_hi(g.w));
        float ss = 0.f;
#pragma unroll
        for (int e = 0; e < 8; ++e) ss += v[e] * v[e];
        const float rs = rsqrtf(wave_sum(ss) * (1.f / 512.f) + EPS);
        v4u o; o.x = pk2(v[0] * rs * og[0], v[1] * rs * og[1]); o.y = pk2(v[2] * rs * og[2], v[3] * rs * og[3]); o.z = pk2(v[4] * rs * og[4], v[5] * rs * og[5]); o.w = pk2(v[6] * rs * og[6], v[7] * rs * og[7]);
        *(v4u*)(Y + (size_t)t * DM + c0) = o; }
    __syncthreads();
}

#ifndef GPSKIP
#define GPSKIP 0
#endif
DI int afrag_off4(int m, int k0, int nct) {
    return ((((m >> 5) * nct + (k0 >> 5)) * 2 + ((k0 >> 4) & 1)) * 64 + (m & 31) + 32 * ((k0 >> 2) & 1)) * 8 + 4 * ((k0 >> 3) & 1);
}
DI void gdn_pre_item(int it, const bf16* Qg, const bf16* Kg, const bf16* Vg, const float* BA, const float* convw, const float* a_log, const float* dt_bias,
                     unsigned char* GOP, float* GL, LAS unsigned char* lds, int tid, int lane, int wid) {
    asm volatile("" : "+v"(lane), "+v"(tid));
    const int n = it & 63, h = (it >> 6) & 3, b = it >> 8, t0 = b * SEQ + 64 * n;
    LAS bf16* KN = (LAS bf16*)(lds); LAS bf16* KB = (LAS bf16*)(lds + 17408); LAS bf16* QS = (LAS bf16*)(lds + 34816);
    LAS bf16* VBT = (LAS bf16*)(lds + 52224); LAS bf16* KBGT = (LAS bf16*)(lds + 70656);
    LAS float* LM = (LAS float*)(lds + 89088); LAS bf16* TB = (LAS bf16*)(lds + 106496);
    LAS float* GC = (LAS float*)(lds + 115712); LAS float* EG = (LAS float*)(lds + 116224); LAS float* EGL = (LAS float*)(lds + 116480);
    LAS bf16* LB21 = (LAS bf16*)(lds + 116736); LAS bf16* TBT = (LAS bf16*)(lds + 119296); LAS bf16* PT = (LAS bf16*)(lds + 121856);
    unsigned char* item = GOP + (size_t)it * GOP_ITEM;
    const int fr = lane & 15, fq = lane >> 4;
    float beta, gc, eg, egl;
    { const float braw = BA[(size_t)(t0 + lane) * 8 + h], araw = BA[(size_t)(t0 + lane) * 8 + 4 + h];
      beta = sigmoidf_(braw);
      const float xs = araw + dt_bias[h]; const float sp = xs > 20.f ? xs : log1pf(__expf(xs));
      float g = -__expf(a_log[h]) * sp;
#pragma unroll
      for (int o = 1; o < 64; o <<= 1) { const float v = __shfl_up(g, o); if (lane >= o) g += v; }
      gc = g; const float gl = __shfl(gc, 63); eg = __expf(gc); egl = __expf(gl - gc);
      if (wid == 0) { GC[lane] = gc; EG[lane] = eg; EGL[lane] = egl; if (lane == 0) GL[it] = gl; } }
    { const int c0 = h * 128 + 2 * lane;
      float wq[4][2], wk[4][2], wv[4][2];
#pragma unroll
      for (int tp = 0; tp < 4; ++tp)
#pragma unroll
          for (int e = 0; e < 2; ++e) { wq[tp][e] = convw[tp * 1536 + c0 + e]; wk[tp][e] = convw[tp * 1536 + 512 + c0 + e]; wv[tp][e] = convw[tp * 1536 + 1024 + c0 + e]; }
      unsigned xq[11], xk[11], xv[11];
#pragma unroll
      for (int r = 0; r < 11; ++r) { const int tok = 8 * wid - 3 + r; const bool ok = (n * 64 + tok) >= 0; const size_t off = (size_t)(t0 + tok) * 512 + c0;
          xq[r] = ok ? *(const unsigned*)(Qg + off) : 0u; xk[r] = ok ? *(const unsigned*)(Kg + off) : 0u; xv[r] = ok ? *(const unsigned*)(Vg + off) : 0u; }
#pragma unroll
      for (int i = 0; i < 8; ++i) { const int tt = 8 * wid + i;
          float q0 = 0.f, q1 = 0.f, k0 = 0.f, k1 = 0.f, v0 = 0.f, v1 = 0.f;
#pragma unroll
          for (int tp = 0; tp < 4; ++tp) { q0 += wq[tp][0] * bf_lo(xq[i + tp]); q1 += wq[tp][1] * bf_hi(xq[i + tp]); k0 += wk[tp][0] * bf_lo(xk[i + tp]); k1 += wk[tp][1] * bf_hi(xk[i + tp]);
              v0 += wv[tp][0] * bf_lo(xv[i + tp]); v1 += wv[tp][1] * bf_hi(xv[i + tp]); }
          q0 = siluf_(q0); q1 = siluf_(q1); k0 = siluf_(k0); k1 = siluf_(k1); v0 = siluf_(v0); v1 = siluf_(v1);
          const float rq = rsqrtf(wave_sum(q0 * q0 + q1 * q1) + EPS) * 0.08838834764831845f, rk = rsqrtf(wave_sum(k0 * k0 + k1 * k1) + EPS);
          const float bt = __shfl(beta, tt), egt = __shfl(eg, tt);
          q0 *= rq; q1 *= rq; k0 *= rk; k1 *= rk;
          *(LAS unsigned*)(KN + tt * 136 + 2 * lane) = pk2(k0, k1);
          *(LAS unsigned*)(KB + tt * 136 + 2 * lane) = pk2(k0 * bt, k1 * bt);
          *(LAS unsigned*)(QS + tt * 136 + 2 * lane) = pk2(q0, q1);
          VBT[(2 * lane) * 72 + tt] = f2bf(v0 * bt); VBT[(2 * lane + 1) * 72 + tt] = f2bf(v1 * bt);
          KBGT[(2 * lane) * 72 + tt] = f2bf(k0 * bt * egt); KBGT[(2 * lane + 1) * 72 + tt] = f2bf(k1 * bt * egt); } }
    __syncthreads();
    { const int sel = wid >> 2, mt = wid & 3;
      bf16x8 a[4];
      const LAS bf16* Asrc = sel == 0 ? KB : KN; const LAS bf16* Bsrc = sel == 0 ? KN : QS;
#pragma unroll
      for (int kk = 0; kk < 4; ++kk) a[kk] = *(const LAS bf16x8*)(Asrc + (16 * mt + fr) * 136 + 32 * kk + 8 * fq);
#pragma unroll
      for (int nt = 0; nt < 4; ++nt) { f32x4 acc = (f32x4){0.f, 0.f, 0.f, 0.f};
#pragma unroll
          for (int kk = 0; kk < 4; ++kk) { const bf16x8 bb = *(const LAS bf16x8*)(Bsrc + (16 * nt + fr) * 136 + 32 * kk + 8 * fq); acc = MFMA16(a[kk], bb, acc); }
          if (sel == 0) {
              const int j = 16 * nt + fr; const float gj = GC[j];
#pragma unroll
              for (int rg = 0; rg < 4; ++rg) { const int i = 16 * mt + 4 * fq + rg; const float lv = (j < i) ? acc[rg] * __expf(GC[i] - gj) : 0.f; LM[i * 68 + j] = lv;
                  if (i >= 32 && j < 32) LB21[(i - 32) * 40 + j] = f2bf(lv); }
          } else {
              const int i = 16 * nt + fr, j0 = 16 * mt + 4 * fq; const float gi = GC[i]; float v[4];
#pragma unroll
              for (int rg = 0; rg < 4; ++rg) { const int j = j0 + rg; v[rg] = (j <= i) ? acc[rg] * __expf(gi - GC[j]) : 0.f; }
              *(v2u*)((bf16*)(item + 49152) + afrag_off4(i, j0, 2)) = (v2u){pk2(v[0], v[1]), pk2(v[2], v[3])};
          } } }
    __syncthreads();
    if (wid == 0) {
        const int hh = lane >> 5, jj = lane & 31;
        float t[32];
#pragma unroll
        for (int i = 0; i < 32; ++i) t[i] = 0.f;
#pragma unroll
        for (int i = 0; i < 32; ++i) { float a0 = 0.f, a1 = 0.f, a2 = 0.f, a3 = 0.f;
#pragma unroll
            for (int k4 = 0; k4 < (i + 3) / 4; ++k4) { const f32x4 l = *(const LAS f32x4*)(LM + (i + 32 * hh) * 68 + 32 * hh + 4 * k4);
                a0 += l.x * t[4 * k4]; a1 += l.y * t[4 * k4 + 1]; a2 += l.z * t[4 * k4 + 2]; a3 += l.w * t[4 * k4 + 3]; }
            t[i] = ((jj == i) ? 1.f : 0.f) - ((a0 + a1) + (a2 + a3)); asm volatile("" ::: "memory"); }
#pragma unroll
        for (int i = 0; i < 32; ++i) TB[(32 * hh + i) * 72 + 32 * hh + jj] = f2bf(t[i]);
        if (hh == 0) {
#pragma unroll
            for (int i = 0; i < 32; ++i) TB[i * 72 + 32 + jj] = (bf16)0;
#pragma unroll
            for (int q = 0; q < 4; ++q) *(LAS bf16x8*)(TBT + jj * 40 + 8 * q) = pack8(t + 8 * q);
        }
        LDS_WAIT(); asm volatile("" ::: "memory");
#pragma unroll
        for (int mt = 0; mt < 2; ++mt)
#pragma unroll
            for (int nt = 0; nt < 2; ++nt) { const bf16x8 aa = *(const LAS bf16x8*)(LB21 + (16 * mt + fr) * 40 + 8 * fq), bb = *(const LAS bf16x8*)(TBT + (16 * nt + fr) * 40 + 8 * fq);
                const f32x4 acc = MFMA16(aa, bb, ((f32x4){0.f, 0.f, 0.f, 0.f}));
                *(LAS v2u*)(PT + (16 * nt + fr) * 40 + 16 * mt + 4 * fq) = (v2u){pk2(acc[0], acc[1]), pk2(acc[2], acc[3])}; }
        LDS_WAIT(); asm volatile("" ::: "memory");
#pragma unroll
        for (int mt = 0; mt < 2; ++mt)
#pragma unroll
            for (int nt = 0; nt < 2; ++nt) { const bf16x8 aa = *(const LAS bf16x8*)(TB + (32 + 16 * mt + fr) * 72 + 32 + 8 * fq), bb = *(const LAS bf16x8*)(PT + (16 * nt + fr) * 40 + 8 * fq);
                const f32x4 acc = MFMA16(aa, bb, ((f32x4){0.f, 0.f, 0.f, 0.f}));
#pragma unroll
                for (int rg = 0; rg < 4; ++rg) TB[(32 + 16 * mt + 4 * fq + rg) * 72 + 16 * nt + fr] = f2bf(-acc[rg]); }
    } else {
        for (int p = tid - 64; p < 2048; p += 448) { const int ln = p & 63, r = ln & 31, hh = ln >> 5; float o8[8];
            if (p < 1024) { const int f = p >> 6, mtile = f >> 3, ct = (f >> 1) & 3, s = f & 1; const int m = 32 * mtile + r, k0 = 32 * ct + 16 * s + 4 * hh; const float sc = EG[m];
                const v2u x0 = *(const LAS v2u*)(QS + m * 136 + k0), x1 = *(const LAS v2u*)(QS + m * 136 + k0 + 8);
                o8[0] = bf_lo(x0.x) * sc; o8[1] = bf_hi(x0.x) * sc; o8[2] = bf_lo(x0.y) * sc; o8[3] = bf_hi(x0.y) * sc; o8[4] = bf_lo(x1.x) * sc; o8[5] = bf_hi(x1.x) * sc; o8[6] = bf_lo(x1.y) * sc; o8[7] = bf_hi(x1.y) * sc;
                *(bf16x8*)((bf16*)(item + 16384) + (size_t)(f * 64 + ln) * 8) = pack8(o8);
            } else { const int f = (p - 1024) >> 6, mtile = f >> 2, ct = (f >> 1) & 1, s = f & 1; const int m = 32 * mtile + r, k0 = 32 * ct + 16 * s + 4 * hh;
#pragma unroll
                for (int j = 0; j < 4; ++j) { o8[j] = bf2f(KN[(k0 + j) * 136 + m]) * EGL[k0 + j]; o8[4 + j] = bf2f(KN[(k0 + 8 + j) * 136 + m]) * EGL[k0 + 8 + j]; }
                *(bf16x8*)((bf16*)(item + 32768) + (size_t)(f * 64 + ln) * 8) = pack8(o8); } }
    }
    __syncthreads();
    if (wid < 4) { const int mt = wid; bf16x8 a[2];
#pragma unroll
        for (int kk = 0; kk < 2; ++kk) a[kk] = *(const LAS bf16x8*)(TB + (16 * mt + fr) * 72 + 32 * kk + 8 * fq);
#pragma unroll
        for (int nt = 0; nt < 8; ++nt) { f32x4 acc = (f32x4){0.f, 0.f, 0.f, 0.f};
#pragma unroll
            for (int kk = 0; kk < 2; ++kk) { const bf16x8 bb = *(const LAS bf16x8*)(VBT + (16 * nt + fr) * 72 + 32 * kk + 8 * fq); acc = MFMA16(a[kk], bb, acc); }
            const int dv = 16 * nt + fr, tok0 = 16 * mt + 4 * fq, tt = tok0 & 31;
            const int off = (((dv >> 5) * 2 + (tok0 >> 5)) * 64 + (dv & 31) + 32 * ((tt >> 2) & 1)) * 16 + 4 * (tt >> 3);
            *(v2u*)((bf16*)(item + 57344) + off) = (v2u){pk2(acc[0], acc[1]), pk2(acc[2], acc[3])}; }
    } else {
#pragma unroll
        for (int mi = 0; mi < 2; ++mi) { const int mtp = 2 * (wid & 3) + mi; bf16x8 a[2];
#pragma unroll
            for (int kk = 0; kk < 2; ++kk) a[kk] = *(const LAS bf16x8*)(KBGT + (16 * mtp + fr) * 72 + 32 * kk + 8 * fq);
#pragma unroll
            for (int nt = 0; nt < 4; ++nt) { f32x4 acc = (f32x4){0.f, 0.f, 0.f, 0.f};
#pragma unroll
                for (int kk = 0; kk < 2; ++kk) { const bf16x8 bb = *(const LAS bf16x8*)(TB + (16 * nt + fr) * 72 + 32 * kk + 8 * fq); acc = MFMA16(a[kk], bb, acc); }
                const int tok = 16 * nt + fr, dk0 = 16 * mtp + 4 * fq;
                *(v2u*)((bf16*)(item) + afrag_off4(tok, dk0, 4)) = (v2u){pk2(acc[0], acc[1]), pk2(acc[2], acc[3])}; } }
    }
    __syncthreads();
}

#define RAW_BAR() do { asm volatile("s_waitcnt lgkmcnt(0)" ::: "memory"); __builtin_amdgcn_s_barrier(); asm volatile("" ::: "memory"); } while (0)
DI void gdn_scan(int bt, const unsigned char* GOP, const float* GL, float* O, LAS unsigned char* lds, int tid, int lane, int wid) {
    const int bh = (bt & 7) + 8 * (bt >> 4), dvh = (bt >> 3) & 1, b = bh >> 2, h = bh & 3;
    const unsigned char* base = GOP + (size_t)(bh * 64) * GOP_ITEM;
    const bool comp = wid < 2;
    const int lt = tid - 128;
    f32x16 S[4];
#pragma unroll
    for (int c = 0; c < 4; ++c)
#pragma unroll
        for (int r = 0; r < 16; ++r) S[c][r] = 0.f;
    v4u stage[11];
#define SCAN_LOAD(nn) do { const unsigned char* ib = base + (size_t)(nn) * GOP_ITEM; \
        _Pragma("unroll") for (int q = 0; q < 11; ++q) { const int p = lt + 384 * q; if (p < 4096) stage[q] = *(const v4u*)(p < 3584 ? ib + p * 16 : ib + 57344 + dvh * 8192 + (p - 3584) * 16); } } while (0)
#define SCAN_STORE(slotp) do { _Pragma("unroll") for (int q = 0; q < 11; ++q) { const int p = lt + 384 * q; if (p < 4096) *(LAS v4u*)((slotp) + p * 16) = stage[q]; } } while (0)
    const int r = lane & 31, hh = lane >> 5, dvt = 2 * dvh + wid;
    if (!comp) {
        SCAN_LOAD(0); SCAN_STORE(lds); SCAN_LOAD(1);
        RAW_BAR();
        for (int n = 0; n < 64; ++n) {
            LAS unsigned char* nsl = lds + ((n + 1) & 1) * 65536;
            if (n + 1 < 64) SCAN_STORE(nsl);
            if (n + 2 < 64) SCAN_LOAD(n + 2);
            RAW_BAR();
        }
    } else {
        RAW_BAR();
        for (int n = 0; n < 64; ++n) {
            LAS unsigned char* sl = lds + (n & 1) * 65536;
#define FRAG(region, f) (*(const LAS bf16x8*)(sl + (region) + ((f) * 64 + lane) * 16))
            const float egl = __expf(ld_f32(GL + bh * 64 + n));
            bf16x8 Sb[4][2];
#pragma unroll
            for (int c = 0; c < 4; ++c) { Sb[c][0] = pack_step<0>(S[c]); Sb[c][1] = pack_step<1>(S[c]); }
            bf16x8 Vb[2][2];
#pragma unroll
            for (int mt = 0; mt < 2; ++mt) { f32x16 X;
#pragma unroll
                for (int q = 0; q < 16; ++q) X[q] = 0.f;
#pragma unroll
                for (int c = 0; c < 4; ++c)
#pragma unroll
                    for (int s = 0; s < 2; ++s) X = MFMA32(FRAG(0, (mt * 4 + c) * 2 + s), Sb[c][s], X);
                const LAS unsigned char* up = sl + 57344 + wid * 4096 + (mt * 64 + lane) * 32;
                const v4u u0 = *(const LAS v4u*)up, u1 = *(const LAS v4u*)(up + 16);
                f32x16 vn;
                vn[0] = bf_lo(u0.x) - X[0]; vn[1] = bf_hi(u0.x) - X[1]; vn[2] = bf_lo(u0.y) - X[2]; vn[3] = bf_hi(u0.y) - X[3];
                vn[4] = bf_lo(u0.z) - X[4]; vn[5] = bf_hi(u0.z) - X[5]; vn[6] = bf_lo(u0.w) - X[6]; vn[7] = bf_hi(u0.w) - X[7];
                vn[8] = bf_lo(u1.x) - X[8]; vn[9] = bf_hi(u1.x) - X[9]; vn[10] = bf_lo(u1.y) - X[10]; vn[11] = bf_hi(u1.y) - X[11];
                vn[12] = bf_lo(u1.z) - X[12]; vn[13] = bf_hi(u1.z) - X[13]; vn[14] = bf_lo(u1.w) - X[14]; vn[15] = bf_hi(u1.w) - X[15];
                Vb[mt][0] = pack_step<0>(vn); Vb[mt][1] = pack_step<1>(vn); }
#pragma unroll
            for (int mt = 0; mt < 2; ++mt) { f32x16 Oa;
#pragma unroll
                for (int q = 0; q < 16; ++q) Oa[q] = 0.f;
#pragma unroll
                for (int c = 0; c < 4; ++c)
#pragma unroll
                    for (int s = 0; s < 2; ++s) Oa = MFMA32(FRAG(16384, (mt * 4 + c) * 2 + s), Sb[c][s], Oa);
#pragma unroll
                for (int c2 = 0; c2 < 2; ++c2)
#pragma unroll
                    for (int s = 0; s < 2; ++s) Oa = MFMA32(FRAG(49152, (mt * 2 + c2) * 2 + s), Vb[c2][s], Oa);
                float* orow = O + (size_t)(b * SEQ + 64 * n + 32 * mt + 4 * hh) * 512 + h * 128 + dvt * 32 + r;
#pragma unroll
                for (int q = 0; q < 16; ++q) orow[(size_t)((q & 3) + 8 * (q >> 2)) * 512] = Oa[q]; }
#pragma unroll
            for (int c4 = 0; c4 < 4; ++c4) { S[c4] = S[c4] * egl;
#pragma unroll
                for (int c2 = 0; c2 < 2; ++c2)
#pragma unroll
                    for (int s = 0; s < 2; ++s) S[c4] = MFMA32(FRAG(32768, (c4 * 2 + c2) * 2 + s), Vb[c2][s], S[c4]); }
#undef FRAG
            RAW_BAR();
        }
    }
#undef SCAN_LOAD
#undef SCAN_STORE
}

DI void gdn_post(const float* O, const bf16* Z, const float* out_g, bf16* Y, int lane, int gw, int NGW) {
    const int c0 = 8 * lane;
    float og[8];
#pragma unroll
    for (int e = 0; e < 8; ++e) og[e] = out_g[(c0 & 127) + e];
    for (int t = gw; t < T; t += NGW) {
        const f32x4 a = *(const f32x4*)(O + (size_t)t * 512 + c0), b = *(const f32x4*)(O + (size_t)t * 512 + c0 + 4);
        const v4u z = *(const v4u*)(Z + (size_t)t * 512 + c0);
        float ss = (a.x * a.x + a.y * a.y) + (a.z * a.z + a.w * a.w) + (b.x * b.x + b.y * b.y) + (b.z * b.z + b.w * b.w);
        ss += __shfl_xor(ss, 1); ss += __shfl_xor(ss, 2); ss += __shfl_xor(ss, 4); ss += __shfl_xor(ss, 8);
        const float rs = rsqrtf(ss * (1.f / 128.f) + EPS);
        v4u o;
        o.x = pk2(a.x * rs * og[0] * siluf_(bf_lo(z.x)), a.y * rs * og[1] * siluf_(bf_hi(z.x)));
        o.y = pk2(a.z * rs * og[2] * siluf_(bf_lo(z.y)), a.w * rs * og[3] * siluf_(bf_hi(z.y)));
        o.z = pk2(b.x * rs * og[4] * siluf_(bf_lo(z.z)), b.y * rs * og[5] * siluf_(bf_hi(z.z)));
        o.w = pk2(b.z * rs * og[6] * siluf_(bf_lo(z.w)), b.w * rs * og[7] * siluf_(bf_hi(z.w)));
        *(v4u*)(Y + (size_t)t * DM + 512 + c0) = o;
    }
}

DI void router_rows(const float* H1, const float* WRT, const float* b_rg, const float* b_re, bf16* XN2, unsigned* cnt, unsigned* TOK, int lane, int gw, int NGW, bool commit) {
    for (int t = gw; t < T; t += NGW) {
        const f32x4* hr = (const f32x4*)(H1 + (size_t)t * DM);
        f32x4 v[4]; float ss = 0.f;
#pragma unroll
        for (int j = 0; j < 4; ++j) { v[j] = hr[lane + 64 * j]; ss += (v[j].x * v[j].x + v[j].y * v[j].y) + (v[j].z * v[j].z + v[j].w * v[j].w); }
        const float rs = rsqrtf(wave_sum(ss) * (1.f / DM) + EPS);
#pragma unroll
        for (int j = 0; j < 4; ++j) *(v2u*)(XN2 + (size_t)t * DM + 4 * (lane + 64 * j)) = (v2u){pk2(v[j].x * rs, v[j].y * rs), pk2(v[j].z * rs, v[j].w * rs)};
        float gl4[4];
#pragma unroll
        for (int c = 0; c < 4; ++c) { const f32x4* wr = (const f32x4*)(WRT + c * 1024); float d = 0.f;
#pragma unroll
            for (int j = 0; j < 4; ++j) { const f32x4 w = wr[lane + 64 * j]; d += (v[j].x * w.x + v[j].y * w.y) + (v[j].z * w.z + v[j].w * w.w); }
            gl4[c] = wave_sum(d) * rs + b_rg[c]; }
        float gmax = gl4[0]; int gs = 0;
#pragma unroll
        for (int c = 1; c < 4; ++c) if (gl4[c] > gmax) { gmax = gl4[c]; gs = c; }
        float den = 0.f;
#pragma unroll
        for (int c = 0; c < 4; ++c) den += __expf(gl4[c] - gmax);
        const float pg = 1.f / den;
        gs = __builtin_amdgcn_readfirstlane(gs);
        float el[8];
#pragma unroll
        for (int i = 0; i < 8; ++i) { const f32x4* wr = (const f32x4*)(WRT + (4 + 8 * gs + i) * 1024); float d = 0.f;
#pragma unroll
            for (int j = 0; j < 4; ++j) { const f32x4 w = wr[lane + 64 * j]; d += (v[j].x * w.x + v[j].y * w.y) + (v[j].z * w.z + v[j].w * w.w); }
            el[i] = wave_sum(d) * rs + b_re[8 * gs + i]; }
        float m0 = el[0]; int i0 = 0;
#pragma unroll
        for (int i = 1; i < 8; ++i) if (el[i] > m0) { m0 = el[i]; i0 = i; }
        float m1 = -3.0e38f; int i1 = 0;
#pragma unroll
        for (int i = 0; i < 8; ++i) if (i != i0 && el[i] > m1) { m1 = el[i]; i1 = i; }
        const float q = __expf(m1 - m0);
        const float g0 = pg / (1.f + q), g1 = pg * q / (1.f + q);
        asm volatile("" :: "v"(g0), "v"(g1), "v"(i0), "v"(i1));
        if (lane == 0 && commit) { const int e0 = 8 * gs + i0, e1 = 8 * gs + i1;
            const unsigned p0 = atomicAdd(cnt + e0, 1u), p1 = atomicAdd(cnt + e1, 1u);
            TOK[t] = (unsigned)e0; TOK[T + t] = (unsigned)e1; TOK[2 * T + t] = __float_as_uint(g0); TOK[3 * T + t] = __float_as_uint(g1); TOK[4 * T + t] = p0; TOK[5 * T + t] = p1; }
    }
}

DI void moe_scatter(const bf16* XN2, const unsigned* cnt, unsigned* TOK, bf16* XS, float* SLOTG, unsigned* TILE, int lane, int gw, int NGW, bool leader) {
    const int c = lane < 32 ? (int)ld_u32(cnt + lane) : 0; const int padded = (c + 255) & ~255;
    int pe = padded;
#pragma unroll
    for (int o = 1; o < 64; o <<= 1) { const int v = __shfl_up(pe, o); if (lane >= o) pe += v; }
    const int ps = pe - padded;
    if (leader) {
        int cle[5] = {0, 0, 0, 0, 0};
#pragma unroll
        for (int e = 0; e < 32; ++e) { const int pee = __shfl(pe, e);
#pragma unroll
            for (int q = 0; q < 5; ++q) cle[q] += (pee <= (lane + 64 * q) * 256) ? 1 : 0; }
#pragma unroll
        for (int q = 0; q < 5; ++q) { const int pm = lane + 64 * q; if (pm < 288) TILE[pm] = (unsigned)(cle[q] < 31 ? cle[q] : 31); }
        const int tot = __shfl(pe, 31);
        if (lane == 0) TILE[300] = (unsigned)(tot >> 8);
    }
    for (int t = gw; t < T; t += NGW) {
        const int e0 = (int)TOK[t], e1 = (int)TOK[T + t];
        const int d0 = __shfl(ps, e0) + (int)TOK[4 * T + t], d1 = __shfl(ps, e1) + (int)TOK[5 * T + t];
        const v4u a = ((const v4u*)(XN2 + (size_t)t * DM))[lane], b = ((const v4u*)(XN2 + (size_t)t * DM))[lane + 64];
        ((v4u*)(XS + (size_t)d0 * DM))[lane] = a; ((v4u*)(XS + (size_t)d0 * DM))[lane + 64] = b;
        ((v4u*)(XS + (size_t)d1 * DM))[lane] = a; ((v4u*)(XS + (size_t)d1 * DM))[lane + 64] = b;
        if (lane == 0) { SLOTG[d0] = __uint_as_float(TOK[2 * T + t]); SLOTG[d1] = __uint_as_float(TOK[3 * T + t]); TOK[6 * T + t] = (unsigned)d0; TOK[7 * T + t] = (unsigned)d1; }
    }
}

DI void moe_combine(float* H1, const bf16* YB, const unsigned* TOK, bf16* XN3, int lane, int gw, int NGW, bool commit) {
    for (int t = gw; t < T; t += NGW) {
        const int d0 = (int)TOK[6 * T + t], d1 = (int)TOK[7 * T + t];
        f32x4* hr = (f32x4*)(H1 + (size_t)t * DM); const v2u* y0 = (const v2u*)(YB + (size_t)d0 * DM); const v2u* y1 = (const v2u*)(YB + (size_t)d1 * DM);
        f32x4 v[4]; float ss = 0.f;
#pragma unroll
        for (int j = 0; j < 4; ++j) { const f32x4 hv = hr[lane + 64 * j]; const v2u a = y0[lane + 64 * j], b = y1[lane + 64 * j];
            v[j].x = hv.x + bf_lo(a.x) + bf_lo(b.x); v[j].y = hv.y + bf_hi(a.x) + bf_hi(b.x); v[j].z = hv.z + bf_lo(a.y) + bf_lo(b.y); v[j].w = hv.w + bf_hi(a.y) + bf_hi(b.y);
            if (commit) hr[lane + 64 * j] = v[j]; ss += (v[j].x * v[j].x + v[j].y * v[j].y) + (v[j].z * v[j].z + v[j].w * v[j].w); }
        const float rs = rsqrtf(wave_sum(ss) * (1.f / DM) + EPS);
#pragma unroll
        for (int j = 0; j < 4; ++j) *(v2u*)(XN3 + (size_t)t * DM + 4 * (lane + 64 * j)) = (v2u){pk2(v[j].x * rs, v[j].y * rs), pk2(v[j].z * rs, v[j].w * rs)};
    }
}

constexpr int NPHASE = 13;
#ifndef TESTSEL
#define TESTSEL 0
#endif
__global__ void __launch_bounds__(512, 2) hymba_fwd(Params P) {
    extern __shared__ __attribute__((aligned(16))) unsigned char lds_raw[];
    LAS unsigned char* lds = (LAS unsigned char*)lds_raw;
    cg::grid_group grid = cg::this_grid();
    const int tid = threadIdx.x, lane = tid & 63, wid = __builtin_amdgcn_readfirstlane(tid >> 6);
    const int G = gridDim.x, bid = blockIdx.x, gw = bid * 8 + wid, NGW = G * 8;
    unsigned char* ws = P.ws;
    bf16* PROJ = (bf16*)(ws + WS_PROJ);
    const bf16* LX = PROJ; const bf16* LG = PROJ + (size_t)T * 512; const bf16* Qg = PROJ + (size_t)2 * T * 512; const bf16* Kg = PROJ + (size_t)3 * T * 512;
    const bf16* Vg = PROJ + (size_t)4 * T * 512; const bf16* Zg = PROJ + (size_t)5 * T * 512;
    unsigned* CTL = (unsigned*)(ws + WS_CTL); unsigned* cnt = CTL; float* RS4 = (float*)(ws + WS_CTL + 4096);
    unsigned* TOK = (unsigned*)(ws + WS_TOK); unsigned* TILE = (unsigned*)(ws + WS_TILE);
    float* H1 = (float*)(ws + WS_H1);
#ifndef PHMASK
#define PHMASK 0xFFFF
#endif
#define IN(k) (((PHMASK >> (k)) & 1) && P.ph_lo <= (k) && (k) < P.ph_hi)
#ifndef REP_PHASE
#define REP_PHASE -1
#endif
#define NREP(k) ((REP_PHASE == (k) || REP_PHASE == 99) ? 2 : 1)
#define REPS(k) for (int rep_ = 0; rep_ < NREP(k); ++rep_)
#define SYNC(k) do { if (IN(k) && IN((k) + 1)) { if ((k) == 0) grid.sync(); else { xcd_barrier(xbar); if (REP_PHASE == 20) xcd_barrier(xbar); } } } while (0)
    volatile LAS unsigned* bst = (volatile LAS unsigned*)(lds + 147392);
    if (tid < 2) bst[tid] = 0u;
    __syncthreads();
    XcdBarrier xbar = xcd_barrier_post((unsigned*)(ws + WS_CTL + 512 * 1024), bst);

    if (IN(0)) REPS(0) phase0(P, lds, tid, lane, wid, gw, NGW);
    SYNC(0);
    if (IN(1)) REPS(1) {
        pg8::Gemm g{(const bf16*)(ws + WS_XN1), (const bf16*)(ws + WS_WINT), T, 3072, 1024}; pg8::StaticOrder S; S.init(T, 3072, G, bid);
        pg8::EpiBf16<0> E{PROJ, 512, nullptr, 512, (size_t)T * 512, 1.f};
        pg8::gemm_phase<pg8::EpiBf16<0>, pg8::StaticOrder, true, true>(lds, g, S, E);
    }
    SYNC(1);
    if (IN(2)) REPS(2) {
        REPS(21) for (int bi = bid; bi < 512; bi += G)
            lru_item(bi, LX, P.in[4], P.in[5], (const bf16*)(ws + WS_WAIF), P.in[7], P.in[9], P.in[10], (float*)(ws + WS_SUM), (unsigned*)(ws + WS_PH), lds, tid, lane, wid);
        REPS(22) for (int it = bid; it < 2048; it += G)
            gdn_pre_item(it, Qg, Kg, Vg, (const float*)(ws + WS_BA), P.in[12], P.in[13], P.in[14], ws + WS_GOP, (float*)(ws + WS_GL), lds, tid, lane, wid);
    }
    SYNC(2);
    if (IN(3)) REPS(3) {
        if (bid < 64) { REPS(23) gdn_scan(bid, ws + WS_GOP, (const float*)(ws + WS_GL), (float*)(ws + WS_O), lds, tid, lane, wid); }
        else REPS(24) for (int bi = bid - 64; bi < 512; bi += G - 64)
            lru_fin_item(bi, (const unsigned*)(ws + WS_PH), LG, (const float*)(ws + WS_SUM), P.in[11], (bf16*)(ws + WS_Y), lds, tid, lane, wid);
    }
    SYNC(3);
    if (IN(4)) REPS(4) gdn_post((const float*)(ws + WS_O), Zg, P.in[15], (bf16*)(ws + WS_Y), lane, gw, NGW);
    SYNC(4);
    if (IN(5)) REPS(5) {
        pg8::Gemm g{(const bf16*)(ws + WS_Y), (const bf16*)(ws + WS_WOUTT), T, 1024, 1024}; pg8::StaticOrder S; S.init(T, 1024, G, bid);
        EpiRes E{H1, P.in[0]};
        pg8::gemm_phase<EpiRes, pg8::StaticOrder, true, true>(lds, g, S, E);
    }
    SYNC(5);
    if (IN(6)) {
        REPS(15) router_rows(H1, (const float*)(ws + WS_WRT), P.in[19], P.in[21], (bf16*)(ws + WS_XN2), cnt, TOK, lane, gw, NGW, rep_ == NREP(15) - 1);
        LAS float* scr = (LAS float*)(lds + wid * 8448);
        REPS(13) for (int it = gw; it < 24576; it += NGW) {
            int r = it;
            if (r < 16384) { const bool up = r >= 8192; r &= 8191; const int e = r >> 8, kb = (r >> 4) & 15, nb = r & 15, n0 = 32 * nb;
                transpose_item((up ? P.in[23] : P.in[22]) + (size_t)e * 1024 * 512, 512, P.in[17], (bf16*)(ws + WS_WGUT), 1024, e * 1024 + (n0 >> 7) * 256 + (up ? 128 : 0) + (n0 & 127), 64 * kb, n0, scr, lane);
            } else { r -= 16384; const int e = r >> 8, kb = (r >> 5) & 7, nb = r & 31;
                transpose_item(P.in[24] + (size_t)e * 512 * 1024, 1024, nullptr, (bf16*)(ws + WS_WDT), 512, e * 1024 + 32 * nb, 64 * kb, 32 * nb, scr, lane); }
        }
    }
    SYNC(6);
    if (IN(7)) REPS(7) moe_scatter((const bf16*)(ws + WS_XN2), cnt, TOK, (bf16*)(ws + WS_XS), (float*)(ws + WS_SLOTG), TILE, lane, gw, NGW, bid == 0 && wid == 0);
    SYNC(7);
    if (IN(8)) REPS(8) {
        const int ntile = (int)__builtin_amdgcn_readfirstlane(ld_u32(TILE + 300));
        pg8::Gemm g{(const bf16*)(ws + WS_XS), (const bf16*)(ws + WS_WGUT), 0, 0, 1024}; MoeSched S{TILE, ntile * 4, G, bid};
        EpiSwiglu E{(bf16*)(ws + WS_HB)};
        pg8::gemm_phase<EpiSwiglu, MoeSched, true, true>(lds, g, S, E);
    }
    SYNC(8);
    if (IN(9)) REPS(9) {
        const int ntile = (int)__builtin_amdgcn_readfirstlane(ld_u32(TILE + 300));
        pg8::Gemm g{(const bf16*)(ws + WS_HB), (const bf16*)(ws + WS_WDT), 0, 0, 512}; MoeSched S{TILE, ntile * 4, G, bid};
        EpiDown E{(bf16*)(ws + WS_YB), (const float*)(ws + WS_SLOTG)};
        pg8::gemm_phase<EpiDown, MoeSched, true, true>(lds, g, S, E);
    }
    SYNC(9);
    if (IN(10)) {
        REPS(16) moe_combine(H1, (const bf16*)(ws + WS_YB), TOK, (bf16*)(ws + WS_XN3), lane, gw, NGW, rep_ == NREP(16) - 1);
        __syncthreads();
        pg8::Gemm g{(const bf16*)(ws + WS_PB), (const bf16*)(ws + WS_WPT), T, 1024, 256}; pg8::StaticOrder S; S.init(T, 1024, G, bid);
        pg8::EpiBf16<0> E{(bf16*)(ws + WS_PE), 1024, nullptr, 0, 0, 1.f};
        REPS(14) pg8::gemm_phase<pg8::EpiBf16<0>, pg8::StaticOrder, true, true>(lds, g, S, E);
    }
    SYNC(10);
    if (IN(11)) REPS(11) {
        pg8::Gemm g{(const bf16*)(ws + WS_XN3), (const bf16*)(ws + WS_WPGT), T, 1024, 1024}; pg8::StaticOrder S; S.init(T, 1024, G, bid);
        EpiPle E{H1, (const bf16*)(ws + WS_PE), RS4, rep_ == NREP(11) - 1};
        pg8::gemm_phase<EpiPle, pg8::StaticOrder, true, true>(lds, g, S, E);
    }
    SYNC(11);
    if (IN(12)) REPS(12) {
        const f32x4* h4 = (const f32x4*)H1; const f32x4* nf4 = (const f32x4*)P.in[28]; f32x4* o4 = (f32x4*)P.out;
        for (int i = bid * 512 + tid; i < T * 256; i += G * 512) { const int t = i >> 8; const float rs = rsqrtf(ld_f32(RS4 + t) * (1.f / DM) + EPS); o4[i] = h4[i] * rs * nf4[i & 255]; }
    }
#undef IN
#undef SYNC
}

extern "C" void kernel_launch(void* const* d_in, const int* in_sizes, int n_in, void* d_out, int out_size, void* d_ws, size_t ws_size, hipStream_t stream) {
    static int grid = 0;
    if (grid == 0) {
        if (n_in != 29 || out_size != T * DM || ws_size < WS_END) { fprintf(stderr, "kernel_launch: unexpected shapes (n_in %d out %d ws %zu)\n", n_in, out_size, ws_size); grid = -1; return; }
        int dev = 0, cus = 0, per_cu = 0;
        hipGetDevice(&dev); hipDeviceGetAttribute(&cus, hipDeviceAttributeMultiprocessorCount, dev);
        hipFuncSetAttribute((const void*)hymba_fwd, hipFuncAttributeMaxDynamicSharedMemorySize, LDS_BYTES);
        hipOccupancyMaxActiveBlocksPerMultiprocessor(&per_cu, (const void*)hymba_fwd, 512, LDS_BYTES);
        (void)hipGetLastError();
        if (per_cu < 1) { fprintf(stderr, "kernel_launch: occupancy query says %d blocks per CU\n", per_cu); per_cu = 1; }
        grid = cus;
    }
    if (grid < 0) return;
    hipMemsetAsync((char*)d_ws + WS_CTL, 0, 1 * MiB, stream);
    Params p{};
    for (int i = 0; i < 29; ++i) p.in[i] = (const float*)d_in[i];
    p.out = (float*)d_out; p.ws = (unsigned char*)d_ws; p.ph_lo = 0; p.ph_hi = NPHASE;
    void* args[] = {&p};
    hipError_t e = hipLaunchCooperativeKernel((const void*)hymba_fwd, dim3(grid), dim3(512), args, LDS_BYTES, stream);
    if (e != hipSuccess) fprintf(stderr, "cooperative launch failed: %s (grid %d)\n", hipGetErrorString(e), grid);
}
```
